# Optimizing an MI355X kernel written in HIP

```python
import math
import jax
import jax.numpy as jnp
from jax import lax
import numpy as np

D_MODEL = 1024
BATCH = 8
SEQ = 2048
DEPTH = 4

GRID_W = 64
CTX_LEN = 256
EPS = 1e-6
N_MOD = 9

POOL_WIDTH = 256
POOL_WINDOWS = (2, 4, 8, 16)
POOL_GROUP = POOL_WIDTH // len(POOL_WINDOWS)

HYENA_WIDTH = 256
HYENA_ORDER = 2
HYENA_EMB_DIM = 33
HYENA_FILTER_ORDER = 64
HYENA_DECAY_TARGET = 1e-2
HYENA_FAST_DECAY_PCT = 0.3
HYENA_SLOW_DECAY_PCT = 1.5

HEAD_DIM = 64
N_Q_HEADS = 8
N_KV_HEADS = 2
GQA_GROUP = N_Q_HEADS // N_KV_HEADS
ATTN_WIDTH = N_Q_HEADS * HEAD_DIM
KV_WIDTH = N_KV_HEADS * HEAD_DIM
AXIS_DIM = HEAD_DIM // 2
ROPE_THETA = 10000.0
Q_BLOCK = 128
ATTN_SCALE = HEAD_DIM ** -0.5

HYENA_OFF = POOL_WIDTH
Q_OFF = HYENA_OFF + (HYENA_ORDER + 1) * HYENA_WIDTH
K_OFF = Q_OFF + ATTN_WIDTH
V_OFF = K_OFF + KV_WIDTH
IN_WIDTH = V_OFF + KV_WIDTH
MIX_WIDTH = POOL_WIDTH + HYENA_WIDTH + ATTN_WIDTH

D_FF = 2816

kernel_name = 'hymba_pool_hyena_gqa_prefix_dit_block'


def rms_norm(x, g):
    xf = x.astype(jnp.float32)
    y = xf * lax.rsqrt(jnp.mean(xf * xf, axis=-1, keepdims=True) + EPS)
    return (y * g.astype(jnp.float32)).astype(x.dtype)


def modulate(h, shift, scale):
    return h * (1 + scale) + shift


def swiglu(h, w_gate, w_up, w_down):
    return (jax.nn.silu(h @ w_gate) * (h @ w_up)) @ w_down


def ffn_half_step(h, g, shift, scale, gate, w_gate, w_up, w_down):
    y = modulate(rms_norm(h, g), shift, scale)
    return h + 0.5 * gate * swiglu(y, w_gate, w_up, w_down)


def multiscale_pool(u, w_pool, pool_scale):
    B, L, _ = u.shape
    uf = u.astype(jnp.float32)
    cs = jnp.concatenate([jnp.zeros((B, 1, POOL_WIDTH), jnp.float32), jnp.cumsum(uf, axis=1)], axis=1)
    t = jnp.arange(L)
    groups = []
    for gi, win in enumerate(POOL_WINDOWS):
        lo = jnp.clip(t - win // 2, 0, L)
        hi = jnp.clip(t - win // 2 + win, 0, L)
        sl = slice(gi * POOL_GROUP, (gi + 1) * POOL_GROUP)
        seg = cs[..., sl]
        window_sum = jnp.take(seg, hi, axis=1) - jnp.take(seg, lo, axis=1)
        count = (hi - lo).astype(jnp.float32)[None, :, None]
        groups.append(window_sum / count - uf[..., sl])
    pooled = jnp.stack(groups, axis=2).astype(u.dtype)
    mixed = jnp.einsum('blgc,gcd->blgd', pooled, w_pool).reshape(B, L, POOL_WIDTH)
    return mixed * pool_scale


def short_conv3(u, w, b):
    up = jnp.pad(u, ((0, 0), (1, 1), (0, 0)))
    return up[:, :-2] * w[0] + up[:, 1:-1] * w[1] + up[:, 2:] * w[2] + b


def hyena_filters(L, f_w1, f_b1, f_w2, f_b2, f_w3, sin_freq):
    f32 = jnp.float32
    t = jnp.linspace(0.0, 1.0, L, dtype=f32)[:, None]
    bands = (HYENA_EMB_DIM - 1) // 2
    w_ang = 2.0 * math.pi * jnp.arange(L, dtype=f32) / L
    freqs = jnp.linspace(1e-4, bands - 1, bands, dtype=f32)
    ang = w_ang[:, None] * freqs[None, :]
    z = jnp.concatenate([t, jnp.cos(ang), -jnp.sin(ang)], axis=-1)
    sf = sin_freq.astype(f32)
    hdn = jnp.sin(sf[0] * (z @ f_w1.astype(f32) + f_b1.astype(f32)))
    hdn = jnp.sin(sf[1] * (hdn @ f_w2.astype(f32) + f_b2.astype(f32)))
    filt = (hdn @ f_w3.astype(f32)).reshape(L, HYENA_ORDER, 2, HYENA_WIDTH)
    max_decay = math.log(HYENA_DECAY_TARGET) / HYENA_FAST_DECAY_PCT
    min_decay = math.log(HYENA_DECAY_TARGET) / HYENA_SLOW_DECAY_PCT
    deltas = jnp.linspace(min_decay, max_decay, HYENA_WIDTH, dtype=f32)
    decay = jnp.exp(-t * jnp.abs(deltas))
    filt = filt * decay[:, None, None, :]
    fwd = filt[:, :, 0]
    bwd = filt[1:, :, 1][::-1]
    k = jnp.concatenate([fwd, jnp.zeros_like(fwd[:1]), bwd], axis=0)
    return k / jnp.sum(jnp.abs(k), axis=0, keepdims=True)


def fft_long_conv(u, k_f):
    L = u.shape[1]
    u_f = jnp.fft.rfft(u, n=2 * L, axis=1)
    return jnp.fft.irfft(u_f * k_f, n=2 * L, axis=1)[:, :L]


def hyena_mixer(proj, conv_w, conv_b, f_w1, f_b1, f_w2, f_b2, f_w3, sin_freq, hy_bias):
    L = proj.shape[1]
    zc = short_conv3(proj, conv_w, conv_b).astype(jnp.float32)
    v, x1, x2 = jnp.split(zc, 3, axis=-1)
    k_f = jnp.fft.rfft(hyena_filters(L, f_w1, f_b1, f_w2, f_b2, f_w3, sin_freq), axis=0)
    hb = hy_bias.astype(jnp.float32)
    y = v
    for o, gate in enumerate((x1, x2)):
        y = gate * (fft_long_conv(y, k_f[:, o]) + hb[o] * y)
    return y.astype(proj.dtype)


def axial_rope_tables(rows):
    f32 = jnp.float32
    row = jnp.repeat(jnp.arange(rows), GRID_W).astype(f32)
    col = jnp.tile(jnp.arange(GRID_W), rows).astype(f32)
    inv_freq = 1.0 / (ROPE_THETA ** (jnp.arange(0, AXIS_DIM, 2, dtype=f32) / AXIS_DIM))
    ang_r = row[:, None] * inv_freq
    ang_c = col[:, None] * inv_freq
    ang = jnp.concatenate([ang_r, ang_r, ang_c, ang_c], axis=-1)
    return jnp.cos(ang), jnp.sin(ang)


def apply_axial_rope(x, cos, sin):
    xf = x.astype(jnp.float32)
    x1, x2, x3, x4 = jnp.split(xf, 4, axis=-1)
    rot = jnp.concatenate([-x2, x1, -x4, x3], axis=-1)
    return (xf * cos[:, None, :] + rot * sin[:, None, :]).astype(x.dtype)


def attn_heads(p, n_heads, g, cos, sin):
    B, S, _ = p.shape
    hd = rms_norm(p.reshape(B, S, n_heads, HEAD_DIM), g)
    if cos is not None:
        hd = apply_axial_rope(hd, cos, sin)
    return hd


def attend(q, k, v):
    s = jnp.einsum('bqkgd,bskd->bkgqs', q, k, preferred_element_type=jnp.float32) * ATTN_SCALE
    p = jax.nn.softmax(s, axis=-1).astype(v.dtype)
    o = jnp.einsum('bkgqs,bskd->bqkgd', p, v)
    return o.reshape(o.shape[0], o.shape[1], ATTN_WIDTH)


def blocked_attention(q, k, v):
    B, L = q.shape[:2]
    qb = jnp.moveaxis(q.reshape(B, L // Q_BLOCK, Q_BLOCK, N_KV_HEADS, GQA_GROUP, HEAD_DIM), 1, 0)
    out = lax.map(lambda qblk: attend(qblk, k, v), qb)
    return jnp.moveaxis(out, 0, 1).reshape(B, L, ATTN_WIDTH)


def setup_inputs(seed: int = 0) -> dict:
    key = jax.random.key(seed)
    ks = jax.random.split(key, 32)
    f32 = jnp.float32

    def nrm(k, shape, scale):
        return jax.random.normal(k, shape, f32) * scale

    return {
        'x': nrm(ks[0], (BATCH, SEQ, D_MODEL), 1.0),
        'c': nrm(ks[1], (BATCH, D_MODEL), 1.0),
        'ctx': nrm(ks[2], (BATCH, CTX_LEN, D_MODEL), 1.0),
        'c_ctx': nrm(ks[3], (D_MODEL,), 1.0),
        'norm_g': 1.0 + nrm(ks[4], (DEPTH, 3, D_MODEL), 0.05),
        'w_mod': nrm(ks[5], (DEPTH, D_MODEL, N_MOD * D_MODEL), D_MODEL ** -0.5),
        'b_mod': nrm(ks[6], (DEPTH, N_MOD * D_MODEL), 0.01),
        'ffn_w_gate': nrm(ks[7], (DEPTH, 2, D_MODEL, D_FF), D_MODEL ** -0.5),
        'ffn_w_up': nrm(ks[8], (DEPTH, 2, D_MODEL, D_FF), D_MODEL ** -0.5),
        'ffn_w_down': nrm(ks[9], (DEPTH, 2, D_FF, D_MODEL), D_FF ** -0.5),
        'w_in': nrm(ks[10], (DEPTH, D_MODEL, IN_WIDTH), D_MODEL ** -0.5),
        'w_out': nrm(ks[11], (DEPTH, MIX_WIDTH, D_MODEL), MIX_WIDTH ** -0.5),
        'pool_w': nrm(ks[12], (DEPTH, len(POOL_WINDOWS), POOL_GROUP, POOL_GROUP), POOL_GROUP ** -0.5),
        'pool_scale': 1.0 + nrm(ks[13], (DEPTH, POOL_WIDTH), 0.1),
        'hyena_conv_w': nrm(ks[14], (DEPTH, 3, (HYENA_ORDER + 1) * HYENA_WIDTH), 3.0 ** -0.5),
        'hyena_conv_b': nrm(ks[15], (DEPTH, (HYENA_ORDER + 1) * HYENA_WIDTH), 0.01),
        'hyena_f_w1': nrm(ks[16], (DEPTH, HYENA_EMB_DIM, HYENA_FILTER_ORDER), HYENA_EMB_DIM ** -0.5),
        'hyena_f_b1': nrm(ks[17], (DEPTH, HYENA_FILTER_ORDER), 0.1),
        'hyena_f_w2': nrm(ks[18], (DEPTH, HYENA_FILTER_ORDER, HYENA_FILTER_ORDER), HYENA_FILTER_ORDER ** -0.5),
        'hyena_f_b2': nrm(ks[19], (DEPTH, HYENA_FILTER_ORDER), 0.1),
        'hyena_f_w3': nrm(ks[20], (DEPTH, HYENA_FILTER_ORDER, HYENA_ORDER * 2 * HYENA_WIDTH), HYENA_FILTER_ORDER ** -0.5),
        'hyena_sin_freq': 1.0 + nrm(ks[21], (DEPTH, 2, HYENA_FILTER_ORDER), 0.1),
        'hyena_bias': nrm(ks[22], (DEPTH, HYENA_ORDER, HYENA_WIDTH), 1.0),
        'q_norm_g': 1.0 + nrm(ks[23], (DEPTH, HEAD_DIM), 0.05),
        'k_norm_g': 1.0 + nrm(ks[24], (DEPTH, HEAD_DIM), 0.05),
    }


def reference(x, c, ctx, c_ctx, norm_g, w_mod, b_mod, ffn_w_gate, ffn_w_up, ffn_w_down,
              w_in, w_out, pool_w, pool_scale, hyena_conv_w, hyena_conv_b,
              hyena_f_w1, hyena_f_b1, hyena_f_w2, hyena_f_b2, hyena_f_w3,
              hyena_sin_freq, hyena_bias, q_norm_g, k_norm_g):
    B, L, D = x.shape
    C = ctx.shape[1]
    rows = L // GRID_W
    cos, sin = axial_rope_tables(rows)
    c_act = jax.nn.silu(c)
    cc_act = jax.nn.silu(c_ctx)
    h, hc = x, ctx
    for l in range(DEPTH):
        last = l == DEPTH - 1
        mx = (c_act @ w_mod[l] + b_mod[l]).reshape(B, N_MOD, 1, D)
        mc = (cc_act @ w_mod[l] + b_mod[l]).reshape(N_MOD, D)
        f1 = (ffn_w_gate[l, 0], ffn_w_up[l, 0], ffn_w_down[l, 0])
        f2 = (ffn_w_gate[l, 1], ffn_w_up[l, 1], ffn_w_down[l, 1])
        hy = (hyena_conv_w[l], hyena_conv_b[l], hyena_f_w1[l], hyena_f_b1[l], hyena_f_w2[l],
              hyena_f_b2[l], hyena_f_w3[l], hyena_sin_freq[l], hyena_bias[l])

        h = ffn_half_step(h, norm_g[l, 0], mx[:, 0], mx[:, 1], mx[:, 2], *f1)
        hc = ffn_half_step(hc, norm_g[l, 0], mc[0], mc[1], mc[2], *f1)

        ux = modulate(rms_norm(h, norm_g[l, 1]), mx[:, 3], mx[:, 4])
        uc = modulate(rms_norm(hc, norm_g[l, 1]), mc[3], mc[4])
        px = ux @ w_in[l]
        pc = uc @ (w_in[l][:, K_OFF:] if last else w_in[l])

        qx = attn_heads(px[..., Q_OFF:K_OFF], N_Q_HEADS, q_norm_g[l], cos, sin)
        qx = qx.reshape(B, L, N_KV_HEADS, GQA_GROUP, HEAD_DIM)
        kx = attn_heads(px[..., K_OFF:V_OFF], N_KV_HEADS, k_norm_g[l], cos, sin)
        vx = px[..., V_OFF:].reshape(B, L, N_KV_HEADS, HEAD_DIM)
        pc_kv = pc[..., -2 * KV_WIDTH:]
        kc = attn_heads(pc_kv[..., :KV_WIDTH], N_KV_HEADS, k_norm_g[l], None, None)
        vc = pc_kv[..., KV_WIDTH:].reshape(B, C, N_KV_HEADS, HEAD_DIM)

        k_all = jnp.concatenate([kx, kc], axis=1)
        v_all = jnp.concatenate([vx, vc], axis=1)
        mix_x = jnp.concatenate([
            multiscale_pool(px[..., :HYENA_OFF], pool_w[l], pool_scale[l]),
            hyena_mixer(px[..., HYENA_OFF:Q_OFF], *hy),
            blocked_attention(qx, k_all, v_all),
        ], axis=-1) @ w_out[l]
        h = h + mx[:, 5] * mix_x

        if not last:
            qc = attn_heads(pc[..., Q_OFF:K_OFF], N_Q_HEADS, q_norm_g[l], None, None)
            qc = qc.reshape(B, C, N_KV_HEADS, GQA_GROUP, HEAD_DIM)
            mix_c = jnp.concatenate([
                multiscale_pool(pc[..., :HYENA_OFF], pool_w[l], pool_scale[l]),
                hyena_mixer(pc[..., HYENA_OFF:Q_OFF], *hy),
                attend(qc, kc, vc),
            ], axis=-1) @ w_out[l]
            hc = hc + mc[5] * mix_c
            hc = ffn_half_step(hc, norm_g[l, 2], mc[6], mc[7], mc[8], *f2)

        h = ffn_half_step(h, norm_g[l, 2], mx[:, 6], mx[:, 7], mx[:, 8], *f2)
    return h
```

```cpp
#include <hip/hip_runtime.h>
#include <hip/hip_cooperative_groups.h>
#include <hip/hip_bf16.h>
#include <cstdio>
#include <cstdint>
#include <cmath>
namespace cg = cooperative_groups;
__device__ __forceinline__ int opaque_tid() { int t = threadIdx.x; asm volatile("" : "+v"(t)); return t; }
namespace pg8 {
#define PG8_LAS __attribute__((address_space(3)))
typedef unsigned short bf16_t;
typedef short bf16x8 __attribute__((ext_vector_type(8)));
typedef float f32x4 __attribute__((ext_vector_type(4)));
typedef unsigned u32x4 __attribute__((ext_vector_type(4)));
constexpr int BM = 256, BK = 64, HALF = 128, HTB = HALF * BK * 2  , STAGE_BYTES = 8 * HTB, NXCD = 8, WGM = 8;

__host__ __device__ __forceinline__ int lds_byte(int r, int c) { const int st = (r >> 4) * 2 + (c >> 5), rr = r & 15, cc = c & 31, ob = rr * 64 + cc * 2; return st * 1024 + (ob ^ (((ob >> 9) & 1) << 5)); }
__host__ __device__ __forceinline__ void stage_rc(int b, int& R, int& C) { const int st = b / 1024, sb = b % 1024, swz = sb ^ (((sb >> 9) & 1) << 5); R = (st >> 1) * 16 + swz / 64; C = (st & 1) * 32 + (swz % 64) / 2; }
__host__ __device__ __forceinline__ int perm32(int rho) { const int n = rho >> 4, i = rho & 15; return 8 * (i >> 2) + 4 * n + (i & 3); }

struct Unit { int pm, pn, ko, nt; };
struct Gemm { const bf16_t* A; const bf16_t* Bt; int M, N, K; };

struct StaticOrder {
    int nM, nN, nwg, G, c;
    __host__ __device__ void init(int M, int N, int G_, int c_) { nM = M / BM; nN = N / BM; nwg = nM * nN; G = G_; c = c_; }
    __host__ __device__ bool next(int i, Unit& u) const {
        const long L = (long)i * G + c; if (L >= nwg) return false;
        int wgid = (int)L; { const int q = nwg / NXCD, r = nwg % NXCD, xcd = wgid % NXCD, off = wgid / NXCD; wgid = (xcd < r ? xcd * (q + 1) : r * (q + 1) + (xcd - r) * q) + off; }
        const int nig = WGM * nN, gid = wgid / nig, fm = gid * WGM, gsz = (nM - fm) < WGM ? (nM - fm) : WGM;
        u.pm = fm + ((wgid % nig) % gsz); u.pn = (wgid % nig) / gsz; u.ko = 0; u.nt = 0; return true;
    }
    __device__ __forceinline__ void a_ready(const Unit&) const {}
    __device__ __forceinline__ void done(const Unit&) const {}
};

__device__ __forceinline__ unsigned cvt_pk_bf16(float lo, float hi) { unsigned r; asm volatile("v_cvt_pk_bf16_f32 %0, %1, %2" : "=v"(r) : "v"(lo), "v"(hi)); return r; }
typedef unsigned u32x2 __attribute__((ext_vector_type(2)));
__device__ __forceinline__ int mod_batch(int pm) { return (pm % 9 == 8) ? 8 : pm / 9; }
__device__ __forceinline__ float sum_fq(float s) {
    { auto rr = __builtin_amdgcn_permlane16_swap(__float_as_uint(s), __float_as_uint(s), false, false); s = __uint_as_float(rr[0]) + __uint_as_float(rr[1]); }
    { auto rr = __builtin_amdgcn_permlane32_swap(__float_as_uint(s), __float_as_uint(s), false, false); s = __uint_as_float(rr[0]) + __uint_as_float(rr[1]); }
    return s;
}
__device__ __forceinline__ void load_rstd(float (&rs)[2][4], const float* SS, const Unit& u, int wr, int fr, int fq) {
    f32x4 p[2][4];
#pragma unroll
    for (int ai = 0; ai < 2; ++ai)
#pragma unroll
        for (int m = 0; m < 4; ++m) p[ai][m] = *(const f32x4*)(SS + (size_t)(u.pm * BM + wr * 64 + fr + ai * HALF + m * 16) * 16 + 4 * fq);
#pragma unroll
    for (int ai = 0; ai < 2; ++ai)
#pragma unroll
        for (int m = 0; m < 4; ++m) { const f32x4 a = p[ai][m]; const float s = sum_fq((a[0] + a[1]) + (a[2] + a[3]));
            rs[ai][m] = __builtin_amdgcn_rsqf(s * (1.0f / 1024.0f) + 1e-6f); }
}
struct EpiSwiGLU {
    static constexpr bool PERM = true, AFTER_DRAIN = false;
    bf16_t* O; const float* SS; const float* sb;
    __device__ __forceinline__ void operator()(const f32x4 (&acc)[2][2][4][2], const Unit& u, int wr, int wc, int fr, int fq) const {
        const int row0 = u.pm * BM + wr * 64 + fr, f0 = u.pn * 128 + wc * 32 + 8 * fq;
        float rs[2][4]; load_rstd(rs, SS, u, wr, fr, fq);
        const float* sbp = sb + (size_t)mod_batch(u.pm) * 5632 + u.pn * BM + wc * 32 + 8 * fq;
        f32x4 bv[2][2];
#pragma unroll
        for (int bj = 0; bj < 2; ++bj)
#pragma unroll
            for (int n = 0; n < 2; ++n) bv[bj][n] = *(const f32x4*)(sbp + bj * HALF + 4 * n);
#pragma unroll
        for (int ai = 0; ai < 2; ++ai)
#pragma unroll
            for (int m = 0; m < 4; ++m) { bf16_t* rowp = O + (size_t)(row0 + ai * HALF + m * 16) * 2816 + f0; const float r = rs[ai][m];
                const f32x4 g0 = acc[ai][0][m][0] * r + bv[0][0], g1 = acc[ai][0][m][1] * r + bv[0][1], u0 = acc[ai][1][m][0] * r + bv[1][0], u1 = acc[ai][1][m][1] * r + bv[1][1];
                const f32x4 a0 = g0 * -1.4426950408889634f, a1 = g1 * -1.4426950408889634f; f32x4 e0, e1;
#pragma unroll
                for (int j = 0; j < 4; ++j) { e0[j] = __builtin_amdgcn_exp2f(a0[j]); e1[j] = __builtin_amdgcn_exp2f(a1[j]); }
                e0 = e0 + 1.0f; e1 = e1 + 1.0f;
#pragma unroll
                for (int j = 0; j < 4; ++j) { e0[j] = __builtin_amdgcn_rcpf(e0[j]); e1[j] = __builtin_amdgcn_rcpf(e1[j]); }
                const f32x4 v0 = (g0 * u0) * e0, v1 = (g1 * u1) * e1;
                typedef float f2_t __attribute__((ext_vector_type(2))); typedef __bf16 b2_t __attribute__((ext_vector_type(2)));
                u32x4 w;
                w.x = __builtin_bit_cast(unsigned, __builtin_convertvector((f2_t){v0[0], v0[1]}, b2_t)); w.y = __builtin_bit_cast(unsigned, __builtin_convertvector((f2_t){v0[2], v0[3]}, b2_t));
                w.z = __builtin_bit_cast(unsigned, __builtin_convertvector((f2_t){v1[0], v1[1]}, b2_t)); w.w = __builtin_bit_cast(unsigned, __builtin_convertvector((f2_t){v1[2], v1[3]}, b2_t));
                *(u32x4*)(rowp) = w; }
    }
};
template <bool HALFSTEP> struct EpiResid {
    static constexpr bool PERM = true, AFTER_DRAIN = false;
    bf16_t* H; const float* modl; float* out; int gate_idx;
    bf16_t* HS; const float* g_next; const float* mod_next; int scale_idx; float* SS;
    float* part;
    __device__ __forceinline__ void operator()(const f32x4 (&acc)[2][2][4][2], const Unit& u, int wr, int wc, int fr, int fq) const {
        const int row0 = u.pm * BM + wr * 64 + fr, col0 = u.pn * BM + wc * 32 + 8 * fq; const int mb = mod_batch(u.pm);
        if (u.nt != 0) { const int sl = (u.ko == 0) ? 0 : (u.ko == 768 ? 1 : (u.ko == 1536 ? 2 : 3)); float* pp = part + ((size_t)sl * 2048 + (u.pm / 9) * 256 + wr * 64 + fr) * 1024 + col0;
#pragma unroll
            for (int ai = 0; ai < 2; ++ai)
#pragma unroll
                for (int m = 0; m < 4; ++m)
#pragma unroll
                    for (int bj = 0; bj < 2; ++bj)
#pragma unroll
                        for (int n = 0; n < 2; ++n) *(f32x4*)(pp + (size_t)(ai * HALF + m * 16) * 1024 + bj * HALF + 4 * n) = acc[ai][bj][m][n];
            return; }
        const float* coef = modl + ((size_t)mb * 9 + gate_idx) * 1024 + col0;
        f32x4 cv[2][2];
#pragma unroll
        for (int bj = 0; bj < 2; ++bj)
#pragma unroll
            for (int n = 0; n < 2; ++n) cv[bj][n] = *(const f32x4*)(coef + bj * HALF + 4 * n) * (HALFSTEP ? 0.5f : 1.0f);
        const int jt = u.pm % 9, bb = u.pm / 9;
        f32x4 v[2][2][4][2];
#pragma unroll
        for (int a_ = 0; a_ < 2; ++a_)
#pragma unroll
            for (int b_ = 0; b_ < 2; ++b_)
#pragma unroll
                for (int m_ = 0; m_ < 4; ++m_)
#pragma unroll
                    for (int n_ = 0; n_ < 2; ++n_) v[a_][b_][m_][n_] = acc[a_][b_][m_][n_];
        u32x4 t[4][2];
#define LDROW(buf, c) do { const bf16_t* rowp = H + (size_t)(u.pm * BM + wr * 64 + fr + ((c) >> 2) * HALF + ((c) & 3) * 16) * 1024 + col0; \
            _Pragma("unroll") for (int bj = 0; bj < 2; ++bj) t[buf][bj] = *(const u32x4*)(rowp + bj * HALF); } while (0)
#define FOLDROW(buf, c) do { _Pragma("unroll") for (int bj = 0; bj < 2; ++bj) { const u32x4 r_ = t[buf][bj]; f32x4 o0_, o1_; \
              o0_[0] = __builtin_bit_cast(float, r_.x << 16); o0_[1] = __builtin_bit_cast(float, r_.x & 0xffff0000u); o0_[2] = __builtin_bit_cast(float, r_.y << 16); o0_[3] = __builtin_bit_cast(float, r_.y & 0xffff0000u); \
              o1_[0] = __builtin_bit_cast(float, r_.z << 16); o1_[1] = __builtin_bit_cast(float, r_.z & 0xffff0000u); o1_[2] = __builtin_bit_cast(float, r_.w << 16); o1_[3] = __builtin_bit_cast(float, r_.w & 0xffff0000u); \
              v[(c) >> 2][bj][(c) & 3][0] = o0_ + cv[bj][0] * v[(c) >> 2][bj][(c) & 3][0]; asm volatile("" : "+v"(v[(c) >> 2][bj][(c) & 3][0])); \
              v[(c) >> 2][bj][(c) & 3][1] = o1_ + cv[bj][1] * v[(c) >> 2][bj][(c) & 3][1]; asm volatile("" : "+v"(v[(c) >> 2][bj][(c) & 3][1])); } } while (0)
#define CHUNK_FENCE() do { asm volatile("" ::: "memory"); __builtin_amdgcn_sched_barrier(0); } while (0)
        LDROW(0, 0); LDROW(1, 1); LDROW(2, 2); LDROW(3, 3); CHUNK_FENCE();
        FOLDROW(0, 0); CHUNK_FENCE(); FOLDROW(1, 1); CHUNK_FENCE(); LDROW(0, 4); LDROW(1, 5); CHUNK_FENCE();
        FOLDROW(2, 2); CHUNK_FENCE(); FOLDROW(3, 3); CHUNK_FENCE(); LDROW(2, 6); LDROW(3, 7); CHUNK_FENCE();
        FOLDROW(0, 4); CHUNK_FENCE(); FOLDROW(1, 5); CHUNK_FENCE(); FOLDROW(2, 6); CHUNK_FENCE(); FOLDROW(3, 7); CHUNK_FENCE();
#undef LDROW
#undef FOLDROW
        f32x4 gs[2][2];
#pragma unroll
        for (int bj = 0; bj < 2; ++bj)
#pragma unroll
            for (int n = 0; n < 2; ++n) gs[bj][n] = *(const f32x4*)(g_next + col0 + bj * HALF + 4 * n) * (1.0f + *(const f32x4*)(mod_next + ((size_t)mb * 9 + scale_idx) * 1024 + col0 + bj * HALF + 4 * n));
        CHUNK_FENCE();
#undef CHUNK_FENCE
#pragma unroll
        for (int ai = 0; ai < 2; ++ai)
#pragma unroll
            for (int m = 0; m < 4; ++m) { const int rr = wr * 64 + fr + ai * HALF + m * 16; const size_t grow = (size_t)(u.pm * BM + rr); bf16_t* rowp = H + grow * 1024 + col0;
                float* orow = (out != nullptr && jt < 8) ? out + ((size_t)bb * 2048 + jt * 256 + rr) * 1024 + col0 : nullptr; float ssq = 0.f;
#pragma unroll
                for (int bj = 0; bj < 2; ++bj) { const f32x4 x0 = v[ai][bj][m][0], x1 = v[ai][bj][m][1];
                    { u32x4 hw; hw.x = cvt_pk_bf16(x0[0], x0[1]); hw.y = cvt_pk_bf16(x0[2], x0[3]); hw.z = cvt_pk_bf16(x1[0], x1[1]); hw.w = cvt_pk_bf16(x1[2], x1[3]); *(u32x4*)(rowp + bj * HALF) = hw; }
                    if (orow) { *(f32x4*)(orow + bj * HALF) = x0; *(f32x4*)(orow + bj * HALF + 4) = x1; }
                    { const f32x4 h0 = x0 * gs[bj][0], h1 = x1 * gs[bj][1]; u32x4 w; w.x = cvt_pk_bf16(h0[0], h0[1]); w.y = cvt_pk_bf16(h0[2], h0[3]); w.z = cvt_pk_bf16(h1[0], h1[1]); w.w = cvt_pk_bf16(h1[2], h1[3]);
                      *(u32x4*)(HS + grow * 1024 + col0 + bj * HALF) = w; }
                    ssq += ((x0[0] * x0[0] + x0[1] * x0[1]) + (x0[2] * x0[2] + x0[3] * x0[3])) + ((x1[0] * x1[0] + x1[1] * x1[1]) + (x1[2] * x1[2] + x1[3] * x1[3])); }
                { ssq = sum_fq(ssq); if (fq == 0) SS[grow * 16 + u.pn * 4 + wc] = ssq; } }
    }
};
struct EpiStoreBf16 {
    static constexpr bool PERM = true, AFTER_DRAIN = false;
    bf16_t* O; int ldc; const float* SS; const float* sb;
    __device__ __forceinline__ void operator()(const f32x4 (&acc)[2][2][4][2], const Unit& u, int wr, int wc, int fr, int fq) const {
        const int row0 = u.pm * BM + wr * 64 + fr, col0 = u.pn * BM + wc * 32 + 8 * fq;
        float rs[2][4]; load_rstd(rs, SS, u, wr, fr, fq);
        const float* sbp = sb + (size_t)mod_batch(u.pm) * ldc + col0;
        f32x4 bv[2][2];
#pragma unroll
        for (int bj = 0; bj < 2; ++bj)
#pragma unroll
            for (int n = 0; n < 2; ++n) bv[bj][n] = *(const f32x4*)(sbp + bj * HALF + 4 * n);
#pragma unroll
        for (int ai = 0; ai < 2; ++ai)
#pragma unroll
            for (int m = 0; m < 4; ++m) { bf16_t* rowp = O + (size_t)(row0 + ai * HALF + m * 16) * ldc + col0; const float r = rs[ai][m];
#pragma unroll
                for (int bj = 0; bj < 2; ++bj) { const f32x4 v0 = acc[ai][bj][m][0] * r + bv[bj][0], v1 = acc[ai][bj][m][1] * r + bv[bj][1];
                    u32x4 w; w.x = cvt_pk_bf16(v0[0], v0[1]); w.y = cvt_pk_bf16(v0[2], v0[3]); w.z = cvt_pk_bf16(v1[0], v1[1]); w.w = cvt_pk_bf16(v1[2], v1[3]);
                    *(u32x4*)(rowp + bj * HALF) = w; } }
    }
};
struct TileOrder {
    StaticOrder so; int mode, nN, G, c;
    __device__ __forceinline__ void init(int M, int N, int G_, int c_, int mode_) { so.init(M, N, G_, c_); mode = mode_; nN = N / BM; G = G_; c = c_; }
    __device__ __forceinline__ bool next(int i, Unit& u) const {
        if (mode == 0) return so.next(i, u);
        const int L = i * G + c;
        if (mode == 1) { if (L >= 64 * nN) return false; const int xcd = L & 7, q = L >> 3; u.pm = xcd * 9 + (q & 7); u.pn = q >> 3; u.ko = 0; u.nt = 0; return true; }
        if (L < 256) { const int xcd = L & 7, s = L >> 3; u.pm = xcd * 9 + (s >> 2); u.pn = s & 3; u.ko = 0; u.nt = 0; return true; }
        const int r = L - 256; if (r >= 128) return false;
        const int xcd = r & 7, s = r >> 3, sl = s & 3; u.pm = xcd * 9 + 8; u.pn = s >> 2;
        u.ko = (sl == 0) ? 0 : (sl == 1 ? 768 : (sl == 2 ? 1536 : 2176)); u.nt = (sl < 2) ? 12 : 10; return true;
    }
    __device__ __forceinline__ void a_ready(const Unit&) const {}
    __device__ __forceinline__ void done(const Unit&) const {}
};
template <class Epi, class Sched, bool ALIGN_EPI = false, bool SP2 = false>
__device__ __forceinline__ void gemm_phase(PG8_LAS unsigned char* lds, const Gemm g, const Sched& S, const Epi& E) {
    const int tid = opaque_tid(), wid = __builtin_amdgcn_readfirstlane(tid >> 6), lane = tid & 63, wr = wid >> 2, wc = wid & 3, fr = lane & 15, fq = lane >> 4;
    const int K = g.K, nt = K / BK;
    unsigned voffA[2], voffB[2];
#pragma unroll
    for (int i = 0; i < 2; ++i) { int R, C; stage_rc(tid * 16 + i * 8192, R, C); const int Rb = Epi::PERM ? ((R & ~31) + perm32(R & 31)) : R;
        voffA[i] = (unsigned)(R * K + C) * 2u; voffB[i] = (unsigned)(Rb * K + C) * 2u; }
    const size_t kstep = (size_t)(BK * 2);
    const size_t hstep = (size_t)HALF * K * 2;
    const size_t tstep = 2 * hstep;
    const unsigned ldsw = (unsigned)wid * 1024u;
    const int aoff = lds_byte(wr * 64 + fr, fq * 8), boff = lds_byte(wc * 32 + fr, fq * 8);
#define PG8_SA(b, h) (((b) * 2 + (h)) * HTB)
#define PG8_SB(b, h) ((4 + (b) * 2 + (h)) * HTB)
#define PG8_STAGE(bufoff, gbase, voff) do { _Pragma("unroll") for (int _i = 0; _i < 2; ++_i) \
        __builtin_amdgcn_global_load_lds((const unsigned*)((const char*)(gbase) + (voff)[_i]), (PG8_LAS unsigned*)(lds + (bufoff) + ldsw + _i * 8192), 16, 0, 0); } while (0)
#define PG8_LDA(dst, b, h) do { _Pragma("unroll") for (int m = 0; m < 4; ++m) _Pragma("unroll") for (int k = 0; k < 2; ++k) dst[m][k] = *(const PG8_LAS bf16x8*)(lds + PG8_SA(b, h) + aoff + m * 2048 + k * 1024); } while (0)
#define PG8_LDB(dst, b, h) do { _Pragma("unroll") for (int n = 0; n < 2; ++n) _Pragma("unroll") for (int k = 0; k < 2; ++k) dst[n][k] = *(const PG8_LAS bf16x8*)(lds + PG8_SB(b, h) + boff + n * 2048 + k * 1024); } while (0)
#define PG8_MMA(ai, bj, At, Bt) do { __builtin_amdgcn_s_setprio(1); _Pragma("unroll") for (int m = 0; m < 4; ++m) _Pragma("unroll") for (int n = 0; n < 2; ++n) _Pragma("unroll") for (int k = 0; k < 2; ++k) \
        acc[ai][bj][m][n] = __builtin_amdgcn_mfma_f32_16x16x32_bf16(Bt[n][k], At[m][k], acc[ai][bj][m][n], 0, 0, 0); __builtin_amdgcn_s_setprio(0); } while (0)
#define PG8_WAIT_V(n) asm volatile("s_waitcnt vmcnt(" #n ")" ::: "memory")
#define PG8_WAIT_L(n) asm volatile("s_waitcnt lgkmcnt(" #n ")" ::: "memory")
#define PG8_BAR __builtin_amdgcn_s_barrier()
#define PG8_SCHED __builtin_amdgcn_sched_barrier(0)
    Unit cur, nxt; int ui = 0;
    if (!S.next(0, cur)) return;
    f32x4 acc[2][2][4][2];
#pragma unroll
    for (int a = 0; a < 2; ++a)
#pragma unroll
        for (int b = 0; b < 2; ++b)
#pragma unroll
            for (int m = 0; m < 4; ++m)
#pragma unroll
                for (int n = 0; n < 2; ++n) acc[a][b][m][n] = (f32x4){0.f, 0.f, 0.f, 0.f};
    bf16x8 At[4][2], B0[2][2], B1[2][2];
    const char* cA = (const char*)g.A + (size_t)cur.pm * tstep + (size_t)cur.ko * 2; const char* cB = (const char*)g.Bt + (size_t)cur.pn * tstep + (size_t)cur.ko * 2;
    int unt = cur.nt ? cur.nt : nt;
    S.a_ready(cur);
    if constexpr (SP2) {
        PG8_STAGE(PG8_SB(0, 0), cB, voffB); PG8_STAGE(PG8_SB(0, 1), cB + hstep, voffB); PG8_STAGE(PG8_SA(0, 0), cA, voffA); PG8_STAGE(PG8_SA(0, 1), cA + hstep, voffA);
        if (wr == 1) PG8_BAR;
        PG8_WAIT_V(2); PG8_BAR;
        PG8_STAGE(PG8_SB(1, 0), cB + kstep, voffB); PG8_STAGE(PG8_SA(1, 0), cA + kstep, voffA); PG8_STAGE(PG8_SB(1, 1), cB + hstep + kstep, voffB);
        PG8_WAIT_V(6); PG8_BAR;
    } else {
        PG8_STAGE(PG8_SB(0, 0), cB, voffB); PG8_STAGE(PG8_SA(0, 0), cA, voffA); PG8_STAGE(PG8_SB(0, 1), cB + hstep, voffB); PG8_STAGE(PG8_SA(0, 1), cA + hstep, voffA);
        if (wr == 1) PG8_BAR;
        PG8_WAIT_V(4); PG8_BAR;
        PG8_STAGE(PG8_SB(1, 0), cB + kstep, voffB); PG8_STAGE(PG8_SA(1, 0), cA + kstep, voffA); PG8_STAGE(PG8_SB(1, 1), cB + hstep + kstep, voffB);
        PG8_WAIT_V(6); PG8_BAR;
    }
    for (;;) {
        const bool has_next = S.next(ui + 1, nxt);
        const char* nA = has_next ? (const char*)g.A + (size_t)nxt.pm * tstep + (size_t)nxt.ko * 2 : cA; const char* nB = has_next ? (const char*)g.Bt + (size_t)nxt.pn * tstep + (size_t)nxt.ko * 2 : cB;
        for (int t = 0; t < unt; t += 2) {
            const bool last = (t == unt - 2);
            const char* a1 = cA + (size_t)(t + 1) * kstep;
            const char* a2 = last ? nA : cA + (size_t)(t + 2) * kstep; const char* b2 = last ? nB : cB + (size_t)(t + 2) * kstep;
            const char* a3 = a2 + kstep; const char* b3 = b2 + kstep;
            if (last && has_next) S.a_ready(nxt);
            if constexpr (SP2) {
            PG8_LDB(B0, 0, 0); PG8_LDB(B1, 0, 1); PG8_SCHED; PG8_LDA(At, 0, 0); PG8_STAGE(PG8_SA(1, 1), a1 + hstep, voffA);
            PG8_WAIT_V(8); PG8_WAIT_L(0); PG8_BAR; PG8_MMA(0, 0, At, B0); PG8_MMA(0, 1, At, B1); PG8_BAR; PG8_SCHED;
            PG8_LDA(At, 0, 1); PG8_STAGE(PG8_SB(0, 0), b2, voffB); PG8_STAGE(PG8_SB(0, 1), b2 + hstep, voffB); PG8_STAGE(PG8_SA(0, 0), a2, voffA);
            PG8_WAIT_V(8); PG8_WAIT_L(0); PG8_BAR; PG8_MMA(1, 0, At, B0); PG8_MMA(1, 1, At, B1); PG8_BAR; PG8_SCHED;
            PG8_LDB(B0, 1, 0); PG8_LDB(B1, 1, 1); PG8_SCHED; PG8_LDA(At, 1, 0); PG8_STAGE(PG8_SA(0, 1), a2 + hstep, voffA);
            PG8_WAIT_V(8); PG8_WAIT_L(0); PG8_BAR; PG8_MMA(0, 0, At, B0); PG8_MMA(0, 1, At, B1); PG8_BAR; PG8_SCHED;
            PG8_LDA(At, 1, 1); PG8_STAGE(PG8_SB(1, 0), b3, voffB); PG8_STAGE(PG8_SB(1, 1), b3 + hstep, voffB); PG8_STAGE(PG8_SA(1, 0), a3, voffA);
            PG8_WAIT_V(8); PG8_WAIT_L(0); PG8_BAR; PG8_MMA(1, 0, At, B0); PG8_MMA(1, 1, At, B1); PG8_BAR; PG8_SCHED;
            } else {
            PG8_LDB(B0, 0, 0); PG8_SCHED; PG8_LDA(At, 0, 0); PG8_STAGE(PG8_SA(1, 1), a1 + hstep, voffA);
            PG8_WAIT_L(8); PG8_BAR; PG8_WAIT_L(0); PG8_MMA(0, 0, At, B0); PG8_BAR; PG8_SCHED;
            PG8_LDB(B1, 0, 1); PG8_STAGE(PG8_SB(0, 0), b2, voffB);
            PG8_BAR; PG8_WAIT_L(0); PG8_MMA(0, 1, At, B1); PG8_BAR;
            PG8_LDA(At, 0, 1); PG8_STAGE(PG8_SA(0, 0), a2, voffA);
            PG8_BAR; PG8_WAIT_L(0); PG8_MMA(1, 0, At, B0); PG8_BAR; PG8_SCHED;
            PG8_STAGE(PG8_SB(0, 1), b2 + hstep, voffB);
            PG8_WAIT_V(6); PG8_BAR; PG8_MMA(1, 1, At, B1); PG8_BAR;
            PG8_LDB(B0, 1, 0); PG8_SCHED; PG8_LDA(At, 1, 0); PG8_STAGE(PG8_SA(0, 1), a2 + hstep, voffA);
            PG8_WAIT_L(8); PG8_BAR; PG8_WAIT_L(0); PG8_MMA(0, 0, At, B0); PG8_BAR; PG8_SCHED;
            PG8_LDB(B1, 1, 1); PG8_STAGE(PG8_SB(1, 0), b3, voffB);
            PG8_BAR; PG8_WAIT_L(0); PG8_MMA(0, 1, At, B1); PG8_BAR;
            PG8_LDA(At, 1, 1); PG8_STAGE(PG8_SA(1, 0), a3, voffA);
            PG8_BAR; PG8_WAIT_L(0); PG8_MMA(1, 0, At, B0); PG8_BAR; PG8_SCHED;
            PG8_STAGE(PG8_SB(1, 1), b3 + hstep, voffB);
            PG8_WAIT_V(6); PG8_BAR; PG8_MMA(1, 1, At, B1); PG8_BAR;
            }
        }
        if constexpr (ALIGN_EPI) { if (wr == 0) PG8_BAR; }
        if constexpr (!Epi::AFTER_DRAIN) { E(acc, cur, wr, wc, fr, fq); S.done(cur); }
        if (!has_next) break;
#pragma unroll
        for (int a = 0; a < 2; ++a)
#pragma unroll
            for (int b = 0; b < 2; ++b)
#pragma unroll
                for (int m = 0; m < 4; ++m)
#pragma unroll
                    for (int n = 0; n < 2; ++n) acc[a][b][m][n] = (f32x4){0.f, 0.f, 0.f, 0.f};
        cur = nxt; cA = nA; cB = nB; ++ui; unt = cur.nt ? cur.nt : nt;
        if constexpr (ALIGN_EPI) { if (wr == 1) PG8_BAR; }
    }
    PG8_WAIT_V(0);
    if constexpr (!ALIGN_EPI) { if (wr == 0) PG8_BAR; }
    PG8_BAR;
    if constexpr (Epi::AFTER_DRAIN) { E.fused(acc, cur, wr, wc, fr, fq, lds, wid, lane); S.done(cur); }
#undef PG8_SA
#undef PG8_SB
#undef PG8_STAGE
#undef PG8_LDA
#undef PG8_LDB
#undef PG8_MMA
#undef PG8_WAIT_V
#undef PG8_WAIT_L
#undef PG8_BAR
#undef PG8_SCHED
}
}
namespace attn_body {
using bf16=__hip_bfloat16;
using bf16x8=__attribute__((ext_vector_type(8)))short;
using s16x4=__attribute__((ext_vector_type(4)))short;
using f32x16=__attribute__((ext_vector_type(16)))float;
using u32x4=__attribute__((ext_vector_type(4)))unsigned;
constexpr int D=64,DM=1792,DMO=1024;
constexpr int NW=8,QBLK=32,QB=QBLK*NW,KVBLK=64;
__device__ __forceinline__ int crow(int r,int hi){return (r&3)+8*(r>>2)+4*hi;}
#define SBAR() __builtin_amdgcn_sched_barrier(0)
__device__ __forceinline__ void cmask(f32x16&p0,f32x16&p1,int jb,int qrel,int hi){
  const float NEG=-INFINITY; int kb=64*jb+4*hi;
  #pragma unroll
  for(int r=0;r<16;++r){int kv=kb+(r&3)+8*(r>>2); if(kv>qrel)p0[r]=NEG; if(kv+32>qrel)p1[r]=NEG;}
}

constexpr int NSLOT=3, SLOTB=8192;
constexpr int LDS_K=0, LDS_V=NSLOT*SLOTB, LDS_WS=2*NSLOT*SLOTB, LDS_OST=LDS_WS+NW*64*4, LDS_BYTES=LDS_OST+NW*4096;
constexpr float C2=0.125f*1.4426950408889634f;
__device__ __forceinline__ void glds16(const void*gsrc,unsigned lds_dst){unsigned keep;
  asm volatile("s_mov_b32 %0, m0\n\ts_mov_b32 m0, %2\n\ts_nop 0\n\tglobal_load_lds_dwordx4 %1, off\n\ts_mov_b32 m0, %0":"=&s"(keep):"v"(gsrc),"s"(lds_dst):"memory");}
__device__ __forceinline__ float max3f(float a,float b,float c){float r;asm("v_max3_f32 %0, %1, %2, %3":"=v"(r):"v"(a),"v"(b),"v"(c));return r;}
__device__ __forceinline__ float max2f(float a,float b){float r;asm("v_max_f32_e32 %0, %1, %2":"=v"(r):"v"(a),"v"(b));return r;}
__device__ __forceinline__ float fadd_s(float a,float b){float r;asm("v_add_f32_e32 %0, %1, %2":"=v"(r):"v"(a),"v"(b));return r;}
__device__ __forceinline__ float fsub_s(float a,float b){float r;asm("v_sub_f32_e32 %0, %1, %2":"=v"(r):"v"(a),"v"(b));return r;}
typedef float f32x2_t __attribute__((ext_vector_type(2))); typedef __bf16 bf16x2_t __attribute__((ext_vector_type(2)));
__device__ __forceinline__ unsigned cvtpk_s(float lo,float hi){f32x2_t v={lo,hi};bf16x2_t b=__builtin_convertvector(v,bf16x2_t);return __builtin_bit_cast(unsigned,b);}
#define WAIT_BAR(N) asm volatile("s_waitcnt vmcnt(" #N ") lgkmcnt(0)\n\ts_barrier":::"memory")

__device__ __forceinline__ void qkt(f32x16&p0,f32x16&p1,const char*Kslot,const bf16x8*qr,const f32x16&negm,int r32,int hi){
  const char*kb=Kslot+hi*1024+r32*16;
  #pragma unroll
  for(int d0=0;d0<4;++d0){
    const bf16x8 b0=*reinterpret_cast<const bf16x8*>(kb+d0*2048);
    const bf16x8 b1=*reinterpret_cast<const bf16x8*>(kb+d0*2048+512);
    if(d0==0){p0=__builtin_amdgcn_mfma_f32_32x32x16_bf16(b0,qr[0],negm,0,0,0);p1=__builtin_amdgcn_mfma_f32_32x32x16_bf16(b1,qr[0],negm,0,0,0);}
    else{p0=__builtin_amdgcn_mfma_f32_32x32x16_bf16(b0,qr[d0],p0,0,0,0);p1=__builtin_amdgcn_mfma_f32_32x32x16_bf16(b1,qr[d0],p1,0,0,0);}}
}
typedef __attribute__((address_space(3))) const char* lds_cptr;
typedef short v4i16_t __attribute__((ext_vector_type(4)));
__device__ __forceinline__ void kload8(bf16x8*kf,lds_cptr kp){
  kf[0]=*(const __attribute__((address_space(3))) bf16x8*)(kp);      kf[1]=*(const __attribute__((address_space(3))) bf16x8*)(kp+512);
  kf[2]=*(const __attribute__((address_space(3))) bf16x8*)(kp+2048); kf[3]=*(const __attribute__((address_space(3))) bf16x8*)(kp+2560);
  kf[4]=*(const __attribute__((address_space(3))) bf16x8*)(kp+4096); kf[5]=*(const __attribute__((address_space(3))) bf16x8*)(kp+4608);
  kf[6]=*(const __attribute__((address_space(3))) bf16x8*)(kp+6144); kf[7]=*(const __attribute__((address_space(3))) bf16x8*)(kp+6656);
}
__device__ __forceinline__ void kload2(bf16x8*kf,lds_cptr kp,int j){ kf[2*j]=*(const __attribute__((address_space(3))) bf16x8*)(kp+j*2048); kf[2*j+1]=*(const __attribute__((address_space(3))) bf16x8*)(kp+j*2048+512); }
__device__ __forceinline__ s16x4 vtr(lds_cptr p){ return __builtin_bit_cast(s16x4,__builtin_amdgcn_ds_read_tr16_b64_v4i16((__attribute__((address_space(3))) v4i16_t*)p)); }
__device__ __forceinline__ float rowmax(const f32x16&p0,const f32x16&p1){
  float a=max3f(p0[0],p0[1],p1[0]),b=max3f(p0[2],p0[3],p1[1]);a=max3f(a,p1[2],p1[3]);
  #pragma unroll
  for(int r=4;r<16;r+=4){a=max3f(a,p0[r],p0[r+1]);b=max3f(b,p0[r+2],p0[r+3]);a=max3f(a,p1[r],p1[r+1]);b=max3f(b,p1[r+2],p1[r+3]);}
  const float m=max2f(a,b);
  auto rr=__builtin_amdgcn_permlane32_swap(__float_as_uint(m),__float_as_uint(m),false,false);
  return max2f(__uint_as_float(rr[0]),__uint_as_float(rr[1]));
}
__device__ __forceinline__ void pv(f32x16*o,int vb,bf16x8 pa0,bf16x8 pa1,bf16x8 pa2,bf16x8 pa3){
  #pragma unroll
  for(int d0=0;d0<2;++d0){s16x4 lo[4],hi[4];
    #pragma unroll
    for(int ks=0;ks<4;++ks){
      asm volatile("ds_read_b64_tr_b16 %0,%1 offset:%c2":"=&v"(lo[ks]):"v"(vb),"i"(d0*4096+ks*1024):"memory");
      asm volatile("ds_read_b64_tr_b16 %0,%1 offset:%c2":"=&v"(hi[ks]):"v"(vb),"i"(d0*4096+ks*1024+512):"memory");}
    asm volatile("s_waitcnt lgkmcnt(0)":::"memory");SBAR();
    #define PK(k) (bf16x8){lo[k][0],lo[k][1],lo[k][2],lo[k][3],hi[k][0],hi[k][1],hi[k][2],hi[k][3]}
    o[d0]=__builtin_amdgcn_mfma_f32_32x32x16_bf16(pa0,PK(0),o[d0],0,0,0);
    o[d0]=__builtin_amdgcn_mfma_f32_32x32x16_bf16(pa1,PK(1),o[d0],0,0,0);
    o[d0]=__builtin_amdgcn_mfma_f32_32x32x16_bf16(pa2,PK(2),o[d0],0,0,0);
    o[d0]=__builtin_amdgcn_mfma_f32_32x32x16_bf16(pa3,PK(3),o[d0],0,0,0);
    #undef PK
  }
}

#ifndef ATTN_STORE16
#define ATTN_STORE16(p,v) (*(u32x4*)(p)=(v))
#endif
template<int THRL> __device__ __forceinline__ void attn_unit(const bf16*Q0,const bf16*__restrict__ Kh,const bf16*__restrict__ Vh,bf16*O0,const int NT,char*shm){
  const int tid=opaque_tid(),lane=tid&63,r32=lane&31,hi=lane>>5; const int wid=__builtin_amdgcn_readfirstlane(tid>>6);
  const bf16*Qw=Q0+(long)(wid*QBLK)*DM;
  const unsigned lds0=(unsigned)(uintptr_t)shm;
  float*wsf=(float*)(shm+LDS_WS)+wid*64;
  const bf16*ksrc=Kh+(long)lane*DM+wid*8;
  const bf16*vsrc=Vh+(long)(16*(wid&3)+(lane>>2))*DM+(wid>>2)*32+(lane&3)*8;
  const unsigned kdst=lds0+LDS_K+wid*1024, vdst=lds0+LDS_V+wid*1024;
  #define DMA_K(t,slot) glds16(ksrc+(long)(t)*KVBLK*DM,(unsigned)__builtin_amdgcn_readfirstlane(kdst+(slot)))
  #define DMA_V(t,slot) glds16(vsrc+(long)(t)*KVBLK*DM,(unsigned)__builtin_amdgcn_readfirstlane(vdst+(slot)))
  const int vb0=(int)(lds0+LDS_V)+((lane>>4)&1)*32+(lane&3)*8+(4*hi+((lane&15)>>2))*64;
  const char*Kbase=shm+LDS_K; bf16x8 kf[8];
  const lds_cptr shm3=(lds_cptr)shm; const lds_cptr kp0=shm3+LDS_K+hi*1024+r32*16; const lds_cptr vp0=shm3+LDS_V+((lane>>4)&1)*32+(lane&3)*8+(4*hi+((lane&15)>>2))*64;
  DMA_K(0,0);DMA_V(0,0);DMA_K(1,SLOTB);
  bf16x8 qr[4];
  #pragma unroll
  for(int d0=0;d0<4;++d0)qr[d0]=*reinterpret_cast<const bf16x8*>(&Qw[(long)r32*DM+d0*16+hi*8]);
  float mhat=0.f,l_reg=0.f;f32x16 o[2];o[0]=f32x16{};o[1]=f32x16{};f32x16 negm=f32x16{};asm volatile("":"+v"(negm));
  #define CMASK(P0,P1,t) do{}while(0)
  bool resc=false;
  #define START(P0,P1) do{ const float rm=rowmax(P0,P1); resc=false; \
    { const float dl=rm; mhat=fadd_s(mhat,dl); \
      _Pragma("unroll") for(int r=0;r<16;++r){P0[r]=fsub_s(P0[r],dl);P1[r]=fsub_s(P1[r],dl);} \
      _Pragma("unroll") for(int r=0;r<16;++r)negm[r]=-mhat; asm volatile("":"+v"(negm)); } \
    _Pragma("unroll") for(int r=0;r<16;++r)P0[r]=__builtin_amdgcn_exp2f(P0[r]); }while(0)
  #define RESC() do{ if(resc){ asm volatile("s_waitcnt lgkmcnt(0)":::"memory"); \
      _Pragma("unroll") for(int d_=0;d_<2;++d_) _Pragma("unroll") for(int r=0;r<16;++r)o[d_][r]*=wsf[crow(r,hi)]; } }while(0)
  f32x16 pA0,pA1,pB0,pB1;
  int sl_prev=0,sl_cur=0,sl_next=SLOTB;
  #define ROT() do{sl_prev=sl_cur;sl_cur=sl_next;sl_next=(sl_next==(NSLOT-1)*SLOTB)?0:sl_next+SLOTB;}while(0)
  DMA_K(2,2*SLOTB);
  WAIT_BAR(3);
  qkt(pA0,pA1,Kbase,qr,negm,r32,hi);asm volatile("s_nop 15\n\ts_nop 7":"+v"(pA0),"+v"(pA1));CMASK(pA0,pA1,0);
  START(pA0,pA1);
  _Pragma("unroll") for(int r=0;r<16;++r)pA1[r]=__builtin_amdgcn_exp2f(pA1[r]);
  WAIT_BAR(0);
  DMA_K(3,0);DMA_V(1,SLOTB);
  ROT();
  kload8(kf,kp0+sl_cur);
  WAIT_BAR(2);
  s16x4 vlo[8],vhi[8]; u32x4 pw0,pw1,pw2,pw3;
  #define PKW(P,B) cvtpk_s(P[B],P[B+1])
  #define PAF(k) __builtin_bit_cast(bf16x8,pw##k)
  #define VFR(i) (bf16x8){vlo[i][0],vlo[i][1],vlo[i][2],vlo[i][3],vhi[i][0],vhi[i][1],vhi[i][2],vhi[i][3]}
  #define PIN(x) asm volatile("":"+v"(x))
  #define MX3(a,b,c) __builtin_fmaxf(__builtin_fmaxf((a),(b)),(c))
  #define GAPA(MF,A0,A1,A2,A3,W0,W1,PW) do{ MF; sacc+=A0; sacc+=A1; sacc+=A2; sacc+=A3; PIN(sacc); W0; W1; PIN(PW); SBAR(); }while(0)
  #define EX(v) __builtin_amdgcn_exp2f(v)
  #define GAPB(MF,X,B) do{ MF; X[B]=EX(X[B]); X[B+1]=EX(X[B+1]); X[B+2]=EX(X[B+2]); X[B+3]=EX(X[B+3]); PIN(X); SBAR(); }while(0)
  #define VRD(i) do{ vlo[i]=vtr(vp_+(((i)>>2)*4096+((i)&3)*1024)); vhi[i]=vtr(vp_+(((i)>>2)*4096+((i)&3)*1024+512)); }while(0)
  #define KRD(G,j) do{ if(G){ kload2(kf,kp0+sl_next,j); SBAR(); } }while(0)
  #define STEP(C0,C1,P0,P1,t,GK,GV,GL) do{ SBAR(); \
    const lds_cptr vp_=vp0+sl_prev; \
    VRD(0); SBAR(); float sacc=(P0[0]+P0[1]); \
    GAPA(C0=__builtin_amdgcn_mfma_f32_32x32x16_bf16(kf[0],qr[0],negm,0,0,0), P0[2],P0[3],P0[4],P0[5],     pw0[0]=PKW(P0,0), pw0[1]=PKW(P0,2), pw0); \
    VRD(4); SBAR(); GAPA(C1=__builtin_amdgcn_mfma_f32_32x32x16_bf16(kf[1],qr[0],negm,0,0,0), P0[6],P0[7],P0[8],P0[9],     pw0[2]=PKW(P0,4), pw0[3]=PKW(P0,6), pw0); \
    VRD(1); SBAR(); GAPA(C0=__builtin_amdgcn_mfma_f32_32x32x16_bf16(kf[2],qr[1],C0,0,0,0),   P0[10],P0[11],P0[12],P0[13], pw1[0]=PKW(P0,8), pw1[1]=PKW(P0,10), pw1); \
    VRD(5); SBAR(); GAPA(C1=__builtin_amdgcn_mfma_f32_32x32x16_bf16(kf[3],qr[1],C1,0,0,0),   P0[14],P0[15],P1[0],P1[1],   pw1[2]=PKW(P0,12),pw1[3]=PKW(P0,14), pw1); \
    VRD(2); SBAR(); GAPA(C0=__builtin_amdgcn_mfma_f32_32x32x16_bf16(kf[4],qr[2],C0,0,0,0),   P1[2],P1[3],P1[4],P1[5],     pw2[0]=PKW(P1,0), pw2[1]=PKW(P1,2), pw2); \
    VRD(6); SBAR(); GAPA(C1=__builtin_amdgcn_mfma_f32_32x32x16_bf16(kf[5],qr[2],C1,0,0,0),   P1[6],P1[7],P1[8],P1[9],     pw2[2]=PKW(P1,4), pw2[3]=PKW(P1,6), pw2); \
    VRD(3); SBAR(); GAPA(C0=__builtin_amdgcn_mfma_f32_32x32x16_bf16(kf[6],qr[3],C0,0,0,0),   P1[10],P1[11],P1[12],P1[13], pw3[0]=PKW(P1,8), pw3[1]=PKW(P1,10), pw3); \
    VRD(7); SBAR(); GAPA(C1=__builtin_amdgcn_mfma_f32_32x32x16_bf16(kf[7],qr[3],C1,0,0,0),   P1[14],P1[15],0.f,0.f,       pw3[2]=PKW(P1,12),pw3[3]=PKW(P1,14), pw3); \
    l_reg+=sacc; \
    if(GK){DMA_K((t)+3,sl_cur);} if(GV){DMA_V((t)+1,sl_next);} \
    CMASK(C0,C1,t); \
    { float a=MX3(C0[0],C0[1],C1[0]),b=MX3(C0[2],C0[3],C1[1]); a=MX3(a,C1[2],C1[3]); \
      _Pragma("unroll") for(int r=4;r<16;r+=4){a=MX3(a,C0[r],C0[r+1]);b=MX3(b,C0[r+2],C0[r+3]);a=MX3(a,C1[r],C1[r+1]);b=MX3(b,C1[r+2],C1[r+3]);} \
      float rm=__builtin_fmaxf(a,b); { auto rr=__builtin_amdgcn_permlane32_swap(__float_as_uint(rm),__float_as_uint(rm),false,false); rm=__builtin_fmaxf(__uint_as_float(rr[0]),__uint_as_float(rr[1])); } \
      resc=false; \
      if(__builtin_expect(__any(rm>(float)THRL),0)){ const float dl=__builtin_fmaxf(rm,0.f); mhat+=dl; \
        _Pragma("unroll") for(int r=0;r<16;++r){C0[r]-=dl;C1[r]-=dl;} \
        _Pragma("unroll") for(int r=0;r<16;++r)negm[r]=-mhat; asm volatile("":"+v"(negm)); \
        const float f=__builtin_amdgcn_exp2f(-dl); l_reg*=f; if(hi==0)wsf[r32]=f; resc=true; } } \
    SBAR(); \
    GAPB(o[0]=__builtin_amdgcn_mfma_f32_32x32x16_bf16(PAF(0),VFR(0),o[0],0,0,0), C0,0); \
    GAPB(o[1]=__builtin_amdgcn_mfma_f32_32x32x16_bf16(PAF(0),VFR(4),o[1],0,0,0), C0,4); \
    KRD(GL,0); GAPB(o[0]=__builtin_amdgcn_mfma_f32_32x32x16_bf16(PAF(1),VFR(1),o[0],0,0,0), C0,8); \
    KRD(GL,1); GAPB(o[1]=__builtin_amdgcn_mfma_f32_32x32x16_bf16(PAF(1),VFR(5),o[1],0,0,0), C0,12); \
    KRD(GL,2); GAPB(o[0]=__builtin_amdgcn_mfma_f32_32x32x16_bf16(PAF(2),VFR(2),o[0],0,0,0), C1,0); \
    KRD(GL,3); GAPB(o[1]=__builtin_amdgcn_mfma_f32_32x32x16_bf16(PAF(2),VFR(6),o[1],0,0,0), C1,4); \
    GAPB(o[0]=__builtin_amdgcn_mfma_f32_32x32x16_bf16(PAF(3),VFR(3),o[0],0,0,0), C1,8); \
    GAPB(o[1]=__builtin_amdgcn_mfma_f32_32x32x16_bf16(PAF(3),VFR(7),o[1],0,0,0), C1,12); \
    }while(0)
  int t=1;
  #undef CMASK
  #define CMASK(P0,P1,t) do{}while(0)
  for(;t+5<NT;t+=2){
    STEP(pB0,pB1,pA0,pA1,t,true,true,true);     WAIT_BAR(2); RESC(); ROT();
    STEP(pA0,pA1,pB0,pB1,t+1,true,true,true);   WAIT_BAR(2); RESC(); ROT();
  }
  #undef CMASK
  #define CMASK(P0,P1,t) do{}while(0)
  #define ENDW(tt) do{ if((tt)+3<NT){WAIT_BAR(2);} else if((tt)+2<NT){WAIT_BAR(1);} else {WAIT_BAR(0);} }while(0)
  for(;t+1<NT;t+=2){
    STEP(pB0,pB1,pA0,pA1,t,(t+3<NT),(t+1<NT),(t+1<NT));       ENDW(t);   RESC(); ROT();
    STEP(pA0,pA1,pB0,pB1,t+1,(t+4<NT),(t+2<NT),(t+2<NT));     ENDW(t+1); RESC(); ROT();
  }
  STEP(pB0,pB1,pA0,pA1,NT-1,false,false,false); RESC();
  { float sacc=pB0[0]+pB0[1]; _Pragma("unroll") for(int r=2;r<16;++r)sacc+=pB0[r]; _Pragma("unroll") for(int r=0;r<16;++r)sacc+=pB1[r]; l_reg+=sacc;
    pw0=(u32x4){PKW(pB0,0),PKW(pB0,2),PKW(pB0,4),PKW(pB0,6)};pw1=(u32x4){PKW(pB0,8),PKW(pB0,10),PKW(pB0,12),PKW(pB0,14)};pw2=(u32x4){PKW(pB1,0),PKW(pB1,2),PKW(pB1,4),PKW(pB1,6)};pw3=(u32x4){PKW(pB1,8),PKW(pB1,10),PKW(pB1,12),PKW(pB1,14)};
    SBAR(); pv(o,vb0+sl_cur,PAF(0),PAF(1),PAF(2),PAF(3)); }
  #undef PKW
  #undef PAF
  #undef VFR
  #undef PIN
  #undef MX3
  #undef GAPA
  #undef GAPB
  #undef EX
  #undef VRD
  #undef KRD
  #undef STEP
  #undef ENDW
  {auto rr=__builtin_amdgcn_permlane32_swap(__float_as_uint(l_reg),__float_as_uint(l_reg),false,false);l_reg=__uint_as_float(rr[0])+__uint_as_float(rr[1]);}
  if(hi==0)wsf[32+r32]=l_reg;asm volatile("s_waitcnt lgkmcnt(0)":::"memory");
  float rli[16];
  #pragma unroll
  for(int r=0;r<16;++r)rli[r]=__builtin_amdgcn_rcpf(wsf[32+crow(r,hi)]);
  bf16*Ow=O0+(long)(wid*QBLK)*DMO;
  { bf16*stg=(bf16*)(shm+LDS_OST)+wid*2048;
    #pragma unroll
    for(int r=0;r<16;++r){const int orow=crow(r,hi);
      #pragma unroll
      for(int d0=0;d0<2;++d0)stg[orow*64+d0*32+r32]=__float2bfloat16(o[d0][r]*rli[r]);}
    asm volatile("s_waitcnt lgkmcnt(0)":::"memory");
    #pragma unroll
    for(int i=0;i<4;++i){const int row=i*8+(lane>>3),ch=lane&7; const u32x4 v=*(const u32x4*)(stg+row*64+ch*8); ATTN_STORE16(Ow+(long)row*DMO+ch*8,v);} }
  asm volatile("s_waitcnt lgkmcnt(0)\n\ts_barrier":::"memory");
  #undef DMA_K
  #undef DMA_V
  #undef CMASK
  #undef START
  #undef RESC
  #undef ROT
}
constexpr int ATTN_LDS_BYTES=LDS_BYTES;
#undef SBAR
#undef WAIT_BAR
}
#define LAS __attribute__((address_space(3)))
typedef unsigned short bf16;
typedef float f32x4 __attribute__((ext_vector_type(4)));
typedef float cpx __attribute__((ext_vector_type(2)));
typedef unsigned u32x2 __attribute__((ext_vector_type(2)));
typedef unsigned u32x4v __attribute__((ext_vector_type(4)));
__device__ __forceinline__ cpx mk2(float a, float b) { cpx r; r.x = a; r.y = b; return r; }
constexpr int NWAVES = 8, NTHR = 512;
constexpr int DM_ = 1024, BATCH = 8, SEQ = 2048, CTXL = 256, DEPTH = 4, DFF = 2816, INW = 1792, RPB = SEQ + CTXL  , MROWS = BATCH * RPB  ;
constexpr float EPS = 1e-6f;
constexpr size_t MiB = 1u << 20;
constexpr size_t WS_MOD = 0, WS_BAR = 1536 * 1024, WS_BAR_BYTES = 16384;
constexpr size_t WS_WGU = 2 * MiB, WS_WD = 90 * MiB, WS_WIN = 134 * MiB, WS_WOUT = 148 * MiB;
constexpr size_t WS_H = 156 * MiB, WS_Y = 228 * MiB, WS_ACT = 264 * MiB, WS_P = 363 * MiB, WS_MIX = 426 * MiB;
constexpr size_t WS_KT = WS_ACT, WS_KTC = WS_ACT + 32 * MiB;
constexpr size_t WS_KF = 462 * MiB, WS_KFC = 526 * MiB, WS_FPART = 534 * MiB, WS_SS = 537 * MiB, WS_SB = 539 * MiB, WS_END = 541 * MiB;
constexpr int SB_IN = 9 * 5632, SB_G2 = SB_IN + 9 * 1792, SB_PER_L = SB_G2 + 9 * 5632;
constexpr int LDS_BYTES = 147456;

struct Args {
    const float *x, *c, *ctx, *c_ctx, *norm_g, *w_mod, *b_mod, *w_gate, *w_up, *w_down, *w_in, *w_out, *pool_w, *pool_scale, *conv_w, *conv_b,
                *f_w1, *f_b1, *f_w2, *f_b2, *f_w3, *sin_freq, *hy_bias, *q_g, *k_g;
    float* out; unsigned char* ws;
};

__device__ __forceinline__ unsigned f2bf(float f) { unsigned u = __builtin_bit_cast(unsigned, f); return (u + 0x7fffu + ((u >> 16) & 1u)) >> 16; }
__device__ __forceinline__ unsigned pk2(float lo, float hi) { return f2bf(lo) | (f2bf(hi) << 16); }
__device__ __forceinline__ float bf2f(bf16 v) { return __builtin_bit_cast(float, (unsigned)v << 16); }
__device__ __forceinline__ float wave_sum(float v) {
#pragma unroll
    for (int o = 1; o < 64; o <<= 1) v += __shfl_xor(v, o);
    return v;
}

__device__ __forceinline__ void transpose_item(const float* W, int K, int N, bf16* WT, int mode, LAS float* scr, int item, int lane) {
    const int nblk = N / 32, kb = item / nblk, nb = item % nblk, k0 = 64 * kb, n0 = 32 * nb;
    { float wv[32];
#pragma unroll
      for (int i = 0; i < 32; ++i) wv[i] = W[(size_t)(k0 + 2 * i + (lane >> 5)) * N + n0 + (lane & 31)];
#pragma unroll
      for (int i = 0; i < 32; ++i) scr[(2 * i + (lane >> 5)) * 33 + (lane & 31)] = wv[i]; }
    asm volatile("s_waitcnt lgkmcnt(0)" ::: "memory");
    const int c = lane & 7;
#pragma unroll
    for (int j = 0; j < 4; ++j) { const int n = (lane >> 3) + 8 * j; const LAS float* s = scr + (8 * c) * 33 + n;
        u32x4v o; o.x = pk2(s[0 * 33], s[1 * 33]); o.y = pk2(s[2 * 33], s[3 * 33]); o.z = pk2(s[4 * 33], s[5 * 33]); o.w = pk2(s[6 * 33], s[7 * 33]);
        const int f = n0 + n; const int drow = (mode == 0) ? f : (256 * (f >> 7) + (f & 127) + (mode == 2 ? 128 : 0));
        *(u32x4v*)(WT + (size_t)drow * K + k0 + 8 * c) = o; }
    asm volatile("s_waitcnt lgkmcnt(0)" ::: "memory");
}

__device__ __forceinline__ void mod_item(const Args& A, int item, LAS unsigned char* lds) {
    const int tid = opaque_tid(); const int lane = tid & 63, wid = tid >> 6; const int l = item / 36, cb = item % 36;
    LAS float* a = (LAS float*)lds;
    LAS float* red = a + 9 * 1024;
    for (int i = tid; i < 9 * 1024; i += NTHR) { const int j = i >> 10, k = i & 1023; const float v = (j < 8) ? A.c[j * 1024 + k] : A.c_ctx[k]; a[i] = v / (1.0f + __expf(-v)); }
    __syncthreads();
    { f32x4 acc[9];
#pragma unroll
      for (int j = 0; j < 9; ++j) acc[j] = (f32x4){0.f, 0.f, 0.f, 0.f};
      const int k0 = wid * 128; const float* wp = A.w_mod + ((size_t)l * 1024 + k0) * 9216 + cb * 256 + lane * 4;
#pragma unroll 16
      for (int kk = 0; kk < 128; ++kk) { const f32x4 w = *(const f32x4*)(wp + (size_t)kk * 9216);
#pragma unroll
          for (int j = 0; j < 9; ++j) acc[j] += w * a[j * 1024 + k0 + kk]; }
#pragma unroll
      for (int j = 0; j < 9; ++j) *(LAS f32x4*)(red + (wid * 9 + j) * 256 + lane * 4) = acc[j]; }
    __syncthreads();
    float* mo = (float*)(A.ws + WS_MOD) + (size_t)l * 9 * 9216 + cb * 256;
    for (int i = tid; i < 9 * 256; i += NTHR) { const int j = i >> 8, col = i & 255; float s = A.b_mod[(size_t)l * 9216 + cb * 256 + col];
#pragma unroll
        for (int w = 0; w < 8; ++w) s += red[(w * 9 + j) * 256 + col];
        mo[(size_t)j * 9216 + col] = s; }
    __syncthreads();
}

__device__ __forceinline__ void filter_item(const Args& A, int item, LAS unsigned char* lds) {
    const int tid = opaque_tid(); const int l = item / 144, r = item % 144; const int Lsel = (r >= 128) ? 1 : 0; const int L = Lsel ? 256 : 2048; const int t0 = (Lsel ? (r - 128) : r) * 16;
    LAS float* z = (LAS float*)lds;
    LAS float* h1 = z + 16 * 33;
    LAS float* h2 = h1 + 16 * 64;
    for (int i = tid; i < 16 * 33; i += NTHR) { const int tt = i / 33, e = i % 33; const int t = t0 + tt; float v;
        if (e == 0) v = (float)t / (float)(L - 1);
        else { const int j = (e - 1) & 15; const float freq = 1e-4f + (float)j * ((15.0f - 1e-4f) / 15.0f); const float ang = (6.283185307179586f * (float)t / (float)L) * freq; v = (e <= 16) ? __cosf(ang) : -__sinf(ang); }
        z[i] = v; }
    __syncthreads();
    const float* w1 = A.f_w1 + (size_t)l * 33 * 64; const float* w2 = A.f_w2 + (size_t)l * 64 * 64; const float* w3 = A.f_w3 + (size_t)l * 64 * 1024;
    for (int i = tid; i < 16 * 64; i += NTHR) { const int tt = i >> 6, j = i & 63; float s = A.f_b1[l * 64 + j];
        for (int e = 0; e < 33; ++e) s += z[tt * 33 + e] * w1[e * 64 + j];
        h1[i] = __sinf(A.sin_freq[(l * 2 + 0) * 64 + j] * s); }
    __syncthreads();
    for (int i = tid; i < 16 * 64; i += NTHR) { const int tt = i >> 6, j = i & 63; float s = A.f_b2[l * 64 + j];
        for (int e = 0; e < 64; ++e) s += h1[tt * 64 + e] * w2[e * 64 + j];
        h2[j * 16 + tt] = __sinf(A.sin_freq[(l * 2 + 1) * 64 + j] * s); }
    __syncthreads();
    float* KT = Lsel ? (float*)(A.ws + WS_KTC) + (size_t)l * 512 * 512 : (float*)(A.ws + WS_KT) + (size_t)l * 512 * 4096;
    float* FP = (float*)(A.ws + WS_FPART) + ((size_t)l * 144 + r) * 1024;
    const float min_decay = -3.0701134573253945f, max_decay = -15.350567286626973f;
#pragma unroll 1
    for (int half = 0; half < 2; ++half) { const int n = tid + half * NTHR; const int o = n >> 9, dir = (n >> 8) & 1, c = n & 255;
        float acc[16];
#pragma unroll
        for (int tt = 0; tt < 16; ++tt) acc[tt] = 0.f;
#pragma unroll 16
        for (int j = 0; j < 64; ++j) { const float w = w3[j * 1024 + n];
#pragma unroll
            for (int q = 0; q < 4; ++q) { const f32x4 hv = *(const LAS f32x4*)(h2 + j * 16 + 4 * q); acc[4 * q] += hv.x * w; acc[4 * q + 1] += hv.y * w; acc[4 * q + 2] += hv.z * w; acc[4 * q + 3] += hv.w * w; } }
        const float delta = fabsf(min_decay + (float)c * ((max_decay - min_decay) / 255.0f));
        float* kp = KT + (size_t)(o * 256 + c) * (2 * L); float asum = 0.f;
#pragma unroll
        for (int tt = 0; tt < 16; ++tt) { const int t = t0 + tt; const float v = acc[tt] * __expf(-((float)t / (float)(L - 1)) * delta);
            if (dir == 0) { kp[t] = v; asum += fabsf(v); } else if (t > 0) { kp[2 * L - t] = v; asum += fabsf(v); } }
        if (dir == 0 && t0 == 0) kp[L] = 0.f;
        FP[n] = asum; }
    __syncthreads();
}

__device__ __forceinline__ cpx cmul(cpx a, cpx b) { return mk2(a.x * b.x - a.y * b.y, a.x * b.y + a.y * b.x); }
__device__ __forceinline__ cpx cmulc(cpx a, cpx b) { return mk2(a.x * b.x + a.y * b.y, a.y * b.x - a.x * b.y); }
__device__ __forceinline__ cpx cadd(cpx a, cpx b) { return mk2(a.x + b.x, a.y + b.y); }
__device__ __forceinline__ cpx csub(cpx a, cpx b) { return mk2(a.x - b.x, a.y - b.y); }
__device__ __forceinline__ cpx cis_rev(float r) { return mk2(__builtin_amdgcn_cosf(r), __builtin_amdgcn_sinf(r)); }
#define PADI(i) ((i) + ((i) >> 4))
__device__ __forceinline__ cpx csq(cpx a) { return mk2(a.x * a.x - a.y * a.y, 2.f * a.x * a.y); }
struct Tw { cpx w, wr; };
__device__ __forceinline__ Tw mktw(cpx w, bool conj) { Tw t; if (conj) { t.w = mk2(w.x, -w.y); t.wr = mk2(w.y, w.x); } else { t.w = w; t.wr = mk2(-w.y, w.x); } return t; }
__device__ __forceinline__ cpx cmt(cpx a, const Tw& t) { return a.xx * t.w + a.yy * t.wr; }
__device__ __forceinline__ void bf4_fwd(cpx& a0, cpx& a1, cpx& a2, cpx& a3, const Tw& w1, const Tw& w2) {
    const cpx b0 = a0 + a2, b2 = cmt(a0 - a2, w1), b1 = a1 + a3, t = cmt(a1 - a3, w1), b3 = mk2(t.y, -t.x);
    a0 = b0 + b1; a1 = cmt(b0 - b1, w2); a2 = b2 + b3; a3 = cmt(b2 - b3, w2);
}
__device__ __forceinline__ void bf4_inv(cpx& c0, cpx& c1, cpx& c2, cpx& c3, const Tw& w1c, const Tw& w2c) {
    const cpx t1 = cmt(c1, w2c), b0 = c0 + t1, b1 = c0 - t1, t3 = cmt(c3, w2c), b2 = c2 + t3, b3 = c2 - t3;
    const cpx u2 = cmt(b2, w1c), t = cmt(b3, w1c), u3 = mk2(-t.y, t.x);
    c0 = b0 + u2; c1 = b1 + u3; c2 = b0 - u2; c3 = b1 - u3;
}
template <bool INV, int lQ> __device__ __forceinline__ void fft_dp(LAS cpx* x, int j) {
    asm volatile("" : "+v"(j));
    constexpr int Q = 1 << lQ, q4 = Q >> 2; const int blk = j >> (lQ - 2), pos0 = j & (q4 - 1), base = (blk << (lQ + 2)) + pos0;
    LAS cpx* xb = x + PADI(base);
    cpx e[4][4];
#pragma unroll
    for (int a = 0; a < 4; ++a)
#pragma unroll
        for (int b = 0; b < 4; ++b) e[a][b] = xb[PADI(a * Q + b * q4)];
    const cpx w10 = cis_rev(-(float)pos0 / (float)(4 * Q)); const cpx w1p = csq(csq(w10)); const Tw t1p = mktw(w1p, INV), t2p = mktw(csq(w1p), INV);
    const cpx C1 = mk2(0.92387953251128674f, -0.38268343236508977f), C2 = mk2(0.70710678118654752f, -0.70710678118654752f), C3 = mk2(0.38268343236508977f, -0.92387953251128674f);
    if (INV) {
#pragma unroll
        for (int a = 0; a < 4; ++a) bf4_inv(e[a][0], e[a][1], e[a][2], e[a][3], t1p, t2p); }
#pragma unroll
    for (int b = 0; b < 4; ++b) { const cpx w1 = (b == 0) ? w10 : cmul(w10, b == 1 ? C1 : (b == 2 ? C2 : C3)); const Tw t1 = mktw(w1, INV), t2 = mktw(csq(w1), INV);
        if (INV) bf4_inv(e[0][b], e[1][b], e[2][b], e[3][b], t1, t2); else bf4_fwd(e[0][b], e[1][b], e[2][b], e[3][b], t1, t2); }
    if (!INV) {
#pragma unroll
        for (int a = 0; a < 4; ++a) bf4_fwd(e[a][0], e[a][1], e[a][2], e[a][3], t1p, t2p); }
#pragma unroll
    for (int a = 0; a < 4; ++a)
#pragma unroll
        for (int b = 0; b < 4; ++b) xb[PADI(a * Q + b * q4)] = e[a][b];
}
template <int N> __device__ __forceinline__ void fft_fwd(LAS cpx* x, int j) {
    if (N == 512) { for (int i = j; i < 256; i += 32) { const cpx a = x[PADI(i)], b = x[PADI(i + 256)]; const cpx w = cis_rev(-(float)i / 512.f); x[PADI(i)] = cadd(a, b); x[PADI(i + 256)] = cmul(csub(a, b), w); } __syncthreads(); }
    if (N != 512) { fft_dp<false, 10>(x, j); __syncthreads(); }
    fft_dp<false, 6>(x, j); __syncthreads();
    fft_dp<false, 2>(x, j); __syncthreads();
}
template <int N> __device__ __forceinline__ void fft_inv(LAS cpx* x, int j) {
    fft_dp<true, 2>(x, j); __syncthreads();
    fft_dp<true, 6>(x, j); __syncthreads();
    if (N != 512) { fft_dp<true, 10>(x, j); __syncthreads(); }
    if (N == 512) { for (int i = j; i < 256; i += 32) { const cpx w = cis_rev(-(float)i / 512.f); const cpx a = x[PADI(i)], b = cmulc(x[PADI(i + 256)], w); x[PADI(i)] = cadd(a, b); x[PADI(i + 256)] = csub(a, b); } __syncthreads(); }
}

template <int L, int CH> __device__ __forceinline__ void filter_fft_item(const Args& A, int item, LAS unsigned char* lds) {
    constexpr int N = 2 * L, TPF = NTHR / CH, NB = N + N / 16, NCH = L / 16; static_assert(TPF * 16 == N && 2 * NCH <= TPF, "geometry");
    const int tid = opaque_tid(); const int fi = tid / TPF, j = tid % TPF; const int l = item / (512 / CH), oc = (item % (512 / CH)) * CH + fi;
    LAS cpx* buf = (LAS cpx*)lds + fi * NB;
    LAS float* redn = (LAS float*)(lds + CH * NB * 8) + fi * TPF;
    { const int o = oc >> 8, c = oc & 255; float v = 0.f;
      if (j < 2 * NCH) { const int chunk = j >> 1, dir = j & 1; v = ((const float*)(A.ws + WS_FPART))[((size_t)l * 144 + (L == 2048 ? 0 : 128) + chunk) * 1024 + o * 512 + dir * 256 + c]; }
      redn[j] = v; __syncthreads();
      for (int st = TPF / 2; st > 0; st >>= 1) { if (j < st) redn[j] += redn[j + st]; __syncthreads(); } }
    const float nrm = redn[0];
    const float* kt = (L == 2048 ? (const float*)(A.ws + WS_KT) : (const float*)(A.ws + WS_KTC)) + ((size_t)l * 512 + oc) * N;
    const float s = 1.0f / (nrm * (float)N);
#pragma unroll
    for (int k = 0; k < 16; ++k) { const int i = j + k * TPF; buf[PADI(i)] = mk2(kt[i] * s, 0.f); }
    __syncthreads();
    fft_fwd<N>(buf, j);
    cpx* kf = (L == 2048 ? (cpx*)(A.ws + WS_KF) : (cpx*)(A.ws + WS_KFC)) + ((size_t)l * 512 + oc) * N;
#pragma unroll
    for (int k = 0; k < 16; ++k) { const int i = j + k * TPF; kf[i] = buf[PADI(i)]; }
    __syncthreads();
}

__device__ __forceinline__ void prologue_rows(const Args& A, int G) {
    const int tid = opaque_tid(); const int lane = tid & 63, wid = tid >> 6; const int gw = blockIdx.x * NWAVES + wid, NGW = G * NWAVES;
    bf16* H = (bf16*)(A.ws + WS_H); bf16* HS = (bf16*)(A.ws + WS_Y); float* SS = (float*)(A.ws + WS_SS);
    const float* g = A.norm_g; const float* mod = (const float*)(A.ws + WS_MOD);
    for (int row = gw; row < MROWS; row += NGW) { const int b = row / RPB, j = row % RPB; const int mb = (j >= SEQ) ? 8 : b;
        const float* src = (j < SEQ) ? A.x + ((size_t)b * SEQ + j) * 1024 : A.ctx + ((size_t)b * CTXL + (j - SEQ)) * 1024;
        const float* scale = mod + ((size_t)mb * 9 + 1) * 1024;
        f32x4 v[4]; float ss = 0.f;
#pragma unroll
        for (int q = 0; q < 4; ++q) { v[q] = *(const f32x4*)(src + 256 * q + 4 * lane); ss += (v[q].x * v[q].x + v[q].y * v[q].y) + (v[q].z * v[q].z + v[q].w * v[q].w); }
#pragma unroll
        for (int q = 0; q < 4; ++q) { const int d = 256 * q + 4 * lane; { u32x2 hw; hw.x = pk2(v[q].x, v[q].y); hw.y = pk2(v[q].z, v[q].w); *(u32x2*)(H + (size_t)row * 1024 + d) = hw; }
            const f32x4 y = v[q] * (*(const f32x4*)(g + d) * (1.0f + *(const f32x4*)(scale + d)));
            u32x2 w; w.x = pk2(y.x, y.y); w.y = pk2(y.z, y.w); *(u32x2*)(HS + (size_t)row * 1024 + d) = w; }
        ss = wave_sum(ss);
        if (lane < 16) SS[(size_t)row * 16 + lane] = (lane == 0) ? ss : 0.f;
    }
}
__device__ __forceinline__ void sb_items(const Args& A, int G, LAS unsigned char* lds) {
    const int tid = opaque_tid(); const int lane = tid & 63, wid = tid >> 6; const int gw = blockIdx.x * NWAVES + wid, NGW = G * NWAVES;
    LAS float* red = (LAS float*)(lds + wid * 16384);
    const float* mod = (const float*)(A.ws + WS_MOD); float* SB = (float*)(A.ws + WS_SB);
    constexpr int TOTAL = DEPTH * 13056; const int per = (TOTAL + NGW - 1) / NGW; const int it0 = gw * per, it1 = (it0 + per < TOTAL) ? it0 + per : TOTAL;
    auto wrow_of = [&](int it) -> const bf16* { const int l = it / 13056, r = it % 13056;
        if (r < 5632) return (const bf16*)(A.ws + WS_WGU) + ((size_t)(l * 2 + 0) * 5632 + r) * 1024;
        if (r < 7424) return (const bf16*)(A.ws + WS_WIN) + ((size_t)l * 1792 + (r - 5632)) * 1024;
        return (const bf16*)(A.ws + WS_WGU) + ((size_t)(l * 2 + 1) * 5632 + (r - 7424)) * 1024; };
    f32x4 shv[9][4]; int cur = -1; u32x4v w0 = (u32x4v){0u, 0u, 0u, 0u}, w1 = w0;
    if (it0 < it1) { const bf16* wr_ = wrow_of(it0); w0 = *(const u32x4v*)(wr_ + lane * 16); w1 = *(const u32x4v*)(wr_ + lane * 16 + 8); }
#pragma unroll 1
    for (int it = it0; it < it1; ++it) { const int l = it / 13056, r = it % 13056; const int reg = (r < 5632) ? 0 : (r < 7424 ? 1 : 2); const int combo = l * 3 + reg;
        const int n = (reg == 0) ? r : (reg == 1 ? r - 5632 : r - 7424), N = (reg == 1) ? 1792 : 5632; float* dst = SB + (size_t)l * SB_PER_L + (reg == 0 ? 0 : (reg == 1 ? SB_IN : SB_G2));
        if (combo != cur) { cur = combo;
#pragma unroll
            for (int mb = 0; mb < 9; ++mb) { const float* sh = mod + ((size_t)(l * 9 + mb) * 9 + 3 * reg) * 1024 + lane * 16;
#pragma unroll
                for (int q = 0; q < 4; ++q) shv[mb][q] = *(const f32x4*)(sh + 4 * q); } }
        float wf[16];
#pragma unroll
        for (int e = 0; e < 4; ++e) { wf[2 * e] = __builtin_bit_cast(float, w0[e] << 16); wf[2 * e + 1] = __builtin_bit_cast(float, w0[e] & 0xffff0000u); wf[8 + 2 * e] = __builtin_bit_cast(float, w1[e] << 16); wf[8 + 2 * e + 1] = __builtin_bit_cast(float, w1[e] & 0xffff0000u); }
        if (it + 1 < it1) { const bf16* wr_ = wrow_of(it + 1); w0 = *(const u32x4v*)(wr_ + lane * 16); w1 = *(const u32x4v*)(wr_ + lane * 16 + 8); }
#pragma unroll
        for (int mb = 0; mb < 9; ++mb) { float s_ = 0.f;
#pragma unroll
            for (int q = 0; q < 4; ++q) { const f32x4 a = shv[mb][q]; s_ += (a.x * wf[4 * q] + a.y * wf[4 * q + 1]) + (a.z * wf[4 * q + 2] + a.w * wf[4 * q + 3]); }
            red[mb * 64 + lane] = s_; }
        asm volatile("s_waitcnt lgkmcnt(0)" ::: "memory");
        if (lane < 9) { const LAS f32x4* rr = (const LAS f32x4*)(red + lane * 64); f32x4 t = rr[0];
#pragma unroll
            for (int q = 1; q < 16; ++q) t += rr[q];
            dst[(size_t)lane * N + n] = (t.x + t.y) + (t.z + t.w); }
        asm volatile("s_waitcnt lgkmcnt(0)" ::: "memory");
    }
}

__device__ __forceinline__ void prep_item(const Args& A, int l, int tt, LAS unsigned char* lds) {
    const int tid = opaque_tid(), lane = tid & 63, wid = tid >> 6;
    const int b = tt / 36, jt = tt % 36; const bool is_ctx = jt >= 32; const int seq_t0 = is_ctx ? (jt - 32) * 64 : jt * 64; const int Lseq = is_ctx ? CTXL : SEQ;
    const int seq_row0 = b * RPB + (is_ctx ? SEQ : 0), row0 = seq_row0 + seq_t0;
    bf16* P = (bf16*)(A.ws + WS_P); bf16* MIX = (bf16*)(A.ws + WS_MIX);
    LAS bf16* U = (LAS bf16*)lds;
    for (int i = tid; i < 80 * 32; i += NTHR) { const int r = i >> 5, ck = i & 31; const int t = seq_t0 - 8 + r; u32x4v v = (u32x4v){0u,0u,0u,0u};
        if (t >= 0 && t < Lseq) v = *(const u32x4v*)(P + (size_t)(seq_row0 + t) * INW + ck * 8);
        *(LAS u32x4v*)(U + r * 256 + ck * 8) = v; }
    { LAS cpx* CS = (LAS cpx*)(lds + 106496);
      LAS float* GV = (LAS float*)(lds + 106496 + 16384);
      if (!is_ctx) for (int i = tid; i < 64 * 32; i += NTHR) { const int tl = i >> 5, a = i & 31; const int t = seq_t0 + tl;
          const float inv_freq = exp2f(-13.287712379549449f * (float)(a & 15) * (1.0f / 16.0f));
          const float ang = ((a & 16) ? (float)(t & 63) : (float)(t >> 6)) * inv_freq; CS[i] = mk2(__cosf(ang), __sinf(ang)); }
      if (tid < 128) GV[tid] = (tid < 64) ? A.q_g[l * 64 + tid] * 0.18033688011112042f : A.k_g[l * 64 + tid - 64];
      __syncthreads();
#pragma unroll 1
      for (int p = tid; p < 640; p += NTHR) { const int tl = p / 10, hd = p - tl * 10; bf16* prow = P + (size_t)(row0 + tl) * INW + 1024 + hd * 64;
          u32x4v raw[8];
#pragma unroll
          for (int q = 0; q < 8; ++q) raw[q] = *(const u32x4v*)(prow + 8 * q);
          float x[64]; float ss = 0.f;
#pragma unroll
          for (int q = 0; q < 8; ++q)
#pragma unroll
              for (int e = 0; e < 4; ++e) { const float lo = __builtin_bit_cast(float, raw[q][e] << 16), hi = __builtin_bit_cast(float, raw[q][e] & 0xffff0000u); x[8 * q + 2 * e] = lo; x[8 * q + 2 * e + 1] = hi; ss += lo * lo + hi * hi; }
          const float r = rsqrtf(ss * (1.0f / 64.0f) + EPS); const LAS float* gv = GV + (hd < 8 ? 0 : 64);
#pragma unroll
          for (int d = 0; d < 64; ++d) x[d] *= r * gv[d];
          if (!is_ctx) { const LAS cpx* cs = CS + tl * 32;
#pragma unroll
              for (int hh = 0; hh < 2; ++hh)
#pragma unroll
                  for (int i = 0; i < 16; ++i) { const cpx c = cs[hh * 16 + i]; const float a = x[hh * 32 + i], b = x[hh * 32 + 16 + i]; x[hh * 32 + i] = a * c.x - b * c.y; x[hh * 32 + 16 + i] = b * c.x + a * c.y; } }
#pragma unroll
          for (int q = 0; q < 8; ++q) { u32x4v w; w.x = pk2(x[8 * q], x[8 * q + 1]); w.y = pk2(x[8 * q + 2], x[8 * q + 3]); w.z = pk2(x[8 * q + 4], x[8 * q + 5]); w.w = pk2(x[8 * q + 6], x[8 * q + 7]);
              *(u32x4v*)(prow + 8 * q) = w; } } }
    __syncthreads();
    LAS bf16* Pb = (LAS bf16*)(lds + 80 * 256 * 2);
    { const int ch = tid & 255, tl0 = (tid >> 8) * 32; const int win = 2 << (ch >> 6), hw = win >> 1; float sw = 0.f;
      for (int q = tl0 + 8 - hw; q < tl0 + 8 + hw; ++q) sw += bf2f(U[q * 256 + ch]);
#pragma unroll 4
      for (int tl = tl0; tl < tl0 + 32; ++tl) { const int t = seq_t0 + tl; int lo = t - hw, hi = lo + win; lo = lo < 0 ? 0 : lo; hi = hi > Lseq ? Lseq : hi;
          Pb[tl * 264 + ch] = (bf16)f2bf(sw * __builtin_amdgcn_rcpf((float)(hi - lo)) - bf2f(U[(tl + 8) * 256 + ch]));
          if (tl < tl0 + 31) sw += bf2f(U[(tl + 8 + hw) * 256 + ch]) - bf2f(U[(tl + 8 - hw) * 256 + ch]); } }
    __syncthreads();
    { typedef short bf16x8v __attribute__((ext_vector_type(8))); const int g = wid >> 1, mh = wid & 1, fr = lane & 15, fq = lane >> 4;
      const float* pw = A.pool_w + (size_t)(l * 4 + g) * 4096;
      bf16x8v bfrag[4][2];
#pragma unroll
      for (int nt = 0; nt < 4; ++nt)
#pragma unroll
          for (int ks = 0; ks < 2; ++ks) { float wv[8];
#pragma unroll
              for (int jj = 0; jj < 8; ++jj) wv[jj] = pw[(ks * 32 + fq * 8 + jj) * 64 + nt * 16 + fr];
              u32x4v pk; pk.x = pk2(wv[0], wv[1]); pk.y = pk2(wv[2], wv[3]); pk.z = pk2(wv[4], wv[5]); pk.w = pk2(wv[6], wv[7]); bfrag[nt][ks] = __builtin_bit_cast(bf16x8v, pk); }
#pragma unroll
      for (int mt = 0; mt < 2; ++mt) { bf16x8v afrag[2];
#pragma unroll
          for (int ks = 0; ks < 2; ++ks) afrag[ks] = *(const LAS bf16x8v*)(Pb + (mh * 32 + mt * 16 + fr) * 264 + g * 64 + ks * 32 + fq * 8);
#pragma unroll
          for (int nt = 0; nt < 4; ++nt) { f32x4 acc = (f32x4){0.f, 0.f, 0.f, 0.f};
#pragma unroll
              for (int ks = 0; ks < 2; ++ks) acc = __builtin_amdgcn_mfma_f32_16x16x32_bf16(afrag[ks], bfrag[nt][ks], acc, 0, 0, 0);
              const float ps = A.pool_scale[l * 256 + g * 64 + nt * 16 + fr];
#pragma unroll
              for (int jj = 0; jj < 4; ++jj) MIX[(size_t)(row0 + mh * 32 + mt * 16 + fq * 4 + jj) * 1024 + g * 64 + nt * 16 + fr] = (bf16)f2bf(acc[jj] * ps); } } }
    __syncthreads();
}

template <int L, int CH> __device__ __forceinline__ void hyena_item(const Args& A, int l, int item, LAS unsigned char* lds) {
    constexpr int N = 2 * L, TPF = NTHR / CH, NB = N + N / 16, NI = L / TPF, NCG = 256 / CH; static_assert(TPF * 16 == N && NI == 8, "geometry");
    const int tid = opaque_tid(); const int fi = tid / TPF, j = tid % TPF; const int bp = item / NCG, c0 = (item % NCG) * CH, c = c0 + fi;
    LAS bf16* raw = (LAS bf16*)lds;
    LAS cpx* buf = (LAS cpx*)(lds + 12 * L * CH) + fi * NB;
    const bf16* P = (const bf16*)(A.ws + WS_P); bf16* MIX = (bf16*)(A.ws + WS_MIX);
    const int rb0 = (2 * bp) * RPB + (L == SEQ ? 0 : SEQ), rb1 = rb0 + RPB;
    { constexpr int NLD = 6 * L * (CH / 2) / NTHR; static_assert(NLD * NTHR == 6 * L * (CH / 2), "load split"); unsigned rv[NLD];
#pragma unroll
      for (int k = 0; k < NLD; ++k) { const int i = tid + k * NTHR; const int cp = i % (CH / 2), rt = i / (CH / 2); const int bs = rt / L, t = rt % L; const int bb = bs / 3, sec = bs % 3;
          rv[k] = *(const unsigned*)(P + (size_t)((bb ? rb1 : rb0) + t) * INW + 256 + sec * 256 + c0 + 2 * cp); }
#pragma unroll
      for (int k = 0; k < NLD; ++k) { const int i = tid + k * NTHR; const int cp = i % (CH / 2), rt = i / (CH / 2); const int bs = rt / L, t = rt % L;
          *(LAS unsigned*)(raw + ((size_t)bs * L + t) * CH + 2 * cp) = rv[k]; } }
    __syncthreads();
    const cpx* KFb = (L == SEQ ? (const cpx*)(A.ws + WS_KF) : (const cpx*)(A.ws + WS_KFC)) + (size_t)l * 512 * N;
    float cw[3][3], cb[3];
#pragma unroll
    for (int sec = 0; sec < 3; ++sec) { cb[sec] = A.conv_b[l * 768 + sec * 256 + c];
#pragma unroll
        for (int tap = 0; tap < 3; ++tap) cw[sec][tap] = A.conv_w[(l * 3 + tap) * 768 + sec * 256 + c]; }
    const float hb0 = A.hy_bias[(l * 2 + 0) * 256 + c], hb1 = A.hy_bias[(l * 2 + 1) * 256 + c];
#define ZC(bb, sec, t) ([&]() -> float { const LAS bf16* bp_ = raw + ((size_t)((bb) * 3 + (sec)) * L) * CH + fi; \
        const float a_ = (t) > 0 ? bf2f(bp_[((t) - 1) * CH]) : 0.f, b_ = bf2f(bp_[(t) * CH]), c_ = (t) < L - 1 ? bf2f(bp_[((t) + 1) * CH]) : 0.f; \
        return cw[sec][0] * a_ + cw[sec][1] * b_ + cw[sec][2] * c_ + cb[sec]; }())
    float yv[NI][2];
#pragma unroll
    for (int i = 0; i < NI; ++i) { const int t = j + TPF * i; yv[i][0] = ZC(0, 0, t); yv[i][1] = ZC(1, 0, t); buf[PADI(t)] = mk2(yv[i][0], yv[i][1]); buf[PADI(t + L)] = mk2(0.f, 0.f); }
    __syncthreads();
#pragma unroll 1
    for (int o = 0; o < 2; ++o) {
        const cpx* kf = KFb + (size_t)(o * 256 + c) * N; cpx kfr[16];
#pragma unroll
        for (int k = 0; k < 16; ++k) kfr[k] = kf[j + k * TPF];
        fft_fwd<N>(buf, j);
#pragma unroll
        for (int k = 0; k < 16; ++k) { const int i = j + k * TPF; buf[PADI(i)] = cmul(buf[PADI(i)], kfr[k]); }
        __syncthreads();
        fft_inv<N>(buf, j);
        const float hb = o ? hb1 : hb0;
#pragma unroll
        for (int i = 0; i < NI; ++i) { const int t = j + TPF * i; const cpx cv = buf[PADI(t)];
            const float g0 = o ? ZC(0, 2, t) : ZC(0, 1, t), g1 = o ? ZC(1, 2, t) : ZC(1, 1, t);
            yv[i][0] = g0 * (cv.x + hb * yv[i][0]); yv[i][1] = g1 * (cv.y + hb * yv[i][1]); }
        __syncthreads();
        if (o == 0) {
#pragma unroll
            for (int i = 0; i < NI; ++i) { const int t = j + TPF * i; buf[PADI(t)] = mk2(yv[i][0], yv[i][1]); buf[PADI(t + L)] = mk2(0.f, 0.f); }
            __syncthreads();
        }
    }
#pragma unroll
    for (int i = 0; i < NI; ++i) { const int t = j + TPF * i; raw[((size_t)0 * L + t) * CH + fi] = (bf16)f2bf(yv[i][0]); raw[((size_t)3 * L + t) * CH + fi] = (bf16)f2bf(yv[i][1]); }
    __syncthreads();
#undef ZC
    for (int i = tid; i < 2 * L * (CH / 2); i += NTHR) { const int cp = i % (CH / 2), rt = i / (CH / 2); const int bb = rt / L, t = rt % L;
        const unsigned v = *(const LAS unsigned*)(raw + ((size_t)(bb * 3) * L + t) * CH + 2 * cp);
        *(unsigned*)(MIX + (size_t)((bb ? rb1 : rb0) + t) * 1024 + 256 + c0 + 2 * cp) = v; }
    __syncthreads();
}

__device__ __forceinline__ void ctx_finalize(const Args& A, const float* modl, int gate_idx, const float* g_next, const float* mod_next, int scale_idx, int G) {
    const int tid = opaque_tid(); const int lane = tid & 63, wid = tid >> 6; const int gw = blockIdx.x * NWAVES + wid, NGW = G * NWAVES;
    bf16* H = (bf16*)(A.ws + WS_H); bf16* HS = (bf16*)(A.ws + WS_Y); float* SS = (float*)(A.ws + WS_SS); const float* PART = (const float*)(A.ws + WS_P);
    for (int r = gw; r < 2048; r += NGW) { const size_t row = (size_t)(r >> 8) * RPB + SEQ + (r & 255); float ss = 0.f;
#pragma unroll
        for (int q = 0; q < 4; ++q) { const int d = 256 * q + 4 * lane;
            f32x4 p = *(const f32x4*)(PART + ((size_t)0 * 2048 + r) * 1024 + d); p += *(const f32x4*)(PART + ((size_t)1 * 2048 + r) * 1024 + d); p += *(const f32x4*)(PART + ((size_t)2 * 2048 + r) * 1024 + d); p += *(const f32x4*)(PART + ((size_t)3 * 2048 + r) * 1024 + d);
            const u32x2 hr = *(const u32x2*)(H + row * 1024 + d); f32x4 h; h[0] = __builtin_bit_cast(float, hr.x << 16); h[1] = __builtin_bit_cast(float, hr.x & 0xffff0000u); h[2] = __builtin_bit_cast(float, hr.y << 16); h[3] = __builtin_bit_cast(float, hr.y & 0xffff0000u);
            h += (*(const f32x4*)(modl + ((size_t)8 * 9 + gate_idx) * 1024 + d) * 0.5f) * p;
            ss += (h[0] * h[0] + h[1] * h[1]) + (h[2] * h[2] + h[3] * h[3]);
            u32x2 hw; hw.x = pk2(h[0], h[1]); hw.y = pk2(h[2], h[3]); *(u32x2*)(H + row * 1024 + d) = hw;
            const f32x4 y = h * (*(const f32x4*)(g_next + d) * (1.0f + *(const f32x4*)(mod_next + ((size_t)8 * 9 + scale_idx) * 1024 + d)));
            u32x2 w; w.x = pk2(y[0], y[1]); w.y = pk2(y[2], y[3]); *(u32x2*)(HS + row * 1024 + d) = w; }
        ss = wave_sum(ss);
        if (lane < 16) SS[row * 16 + lane] = (lane == 0) ? ss : 0.f; }
}

#define XB_TMO      128
#define XB_XCNT(j)  (256  + 64 * (j))
#define XB_XSUB(j)  (1280 + 64 * (j))
#define XB_XGEN(j)  (2304 + 64 * (j))
#define XB_TOP      3328
#define XB_TOPGEN   3392
#define XCD_BAR_WORDS 3456
#define XB_SPIN_CAP (1u << 18)

__device__ __forceinline__ unsigned xb_ld(unsigned* p)              { return __hip_atomic_load(p, __ATOMIC_RELAXED, __HIP_MEMORY_SCOPE_AGENT); }
__device__ __forceinline__ unsigned xb_add(unsigned* p, unsigned v) { return __hip_atomic_fetch_add(p, v, __ATOMIC_RELAXED, __HIP_MEMORY_SCOPE_AGENT); }
__device__ __forceinline__ unsigned xb_xcc_id() { return (unsigned)__builtin_amdgcn_s_getreg((3 << 11) | 20) & 0xFu; }
#define XB_SPIN(cond, bar) do { unsigned _sp = 0; while (cond) { __builtin_amdgcn_s_sleep(1); \
    if ((++_sp & 255u) == 0u) { if (xb_ld(&(bar)[XB_TMO])) break; if (_sp > XB_SPIN_CAP) { atomicAdd(&(bar)[XB_TMO], 1u); break; } } } } while (0)

struct XcdBarrier {
    unsigned* bar; unsigned x;
    volatile LAS unsigned* st;
};

__device__ __forceinline__ XcdBarrier xcd_barrier_post(unsigned* bar, volatile LAS unsigned* st) {
    XcdBarrier b; b.bar = bar; b.x = xb_xcc_id(); b.st = st;
    if (threadIdx.x == 0) (void)xb_add(&bar[XB_XCNT(b.x)], 1u);
    return b;
}
__device__ __forceinline__ void xcd_barrier_complete(unsigned* bar, unsigned x, unsigned& nloc, unsigned& nx) {
    const unsigned G = gridDim.x * gridDim.y * gridDim.z;
    unsigned sum, cnt, mine, sp = 0u;
    for (;;) {
        sum = 0u; cnt = 0u; mine = 0u;
#pragma unroll
        for (unsigned j = 0; j < 16; ++j) { const unsigned c = xb_ld(&bar[XB_XCNT(j)]); sum += c; cnt += (c > 0u) ? 1u : 0u; mine = (j == x) ? c : mine; }
        if (sum == G) break;
        __builtin_amdgcn_s_sleep(1);
        if ((++sp & 255u) == 0u) { if (xb_ld(&bar[XB_TMO])) break; if (sp > XB_SPIN_CAP) { atomicAdd(&bar[XB_TMO], 1u); break; } }
    }
    nloc = mine > 0u ? mine : 1u; nx = cnt > 0u ? cnt : 1u;
}

__device__ __forceinline__ void xcd_barrier(const XcdBarrier& b) {
    asm volatile("s_waitcnt vmcnt(0)" ::: "memory");
    __syncthreads();
    if (threadIdx.x == 0) {
        unsigned* bar = b.bar;
        __builtin_amdgcn_s_waitcnt(0);
        unsigned nloc = b.st[0], nx = b.st[1];
        if (nloc == 0u) { xcd_barrier_complete(bar, b.x, nloc, nx); b.st[0] = nloc; b.st[1] = nx; }
        const unsigned old = xb_add(&bar[XB_XSUB(b.x)], 1u);
        const unsigned gen = old / nloc;
        if (old + 1u == (gen + 1u) * nloc) {
            __builtin_amdgcn_fence(__ATOMIC_RELEASE, "agent");
            asm volatile("s_waitcnt vmcnt(0)" ::: "memory");
            const unsigned og = xb_add(&bar[XB_TOP], 1u);
            const unsigned tg = og / nx;
            if (og + 1u == (tg + 1u) * nx) xb_add(&bar[XB_TOPGEN], 1u);
            else XB_SPIN(xb_ld(&bar[XB_TOPGEN]) == tg, bar);
            __builtin_amdgcn_fence(__ATOMIC_ACQUIRE, "agent");
            xb_add(&bar[XB_XGEN(b.x)], 1u);
            asm volatile("s_waitcnt vmcnt(0)" ::: "memory");
        } else {
            XB_SPIN(xb_ld(&bar[XB_XGEN(b.x)]) == gen, bar);
            __builtin_amdgcn_fence(__ATOMIC_ACQUIRE, "agent");
            asm volatile("s_waitcnt vmcnt(0)" ::: "memory");
        }
    }
    __syncthreads();
}

__global__ void __launch_bounds__(NTHR, 2) fwd_megakernel(Args A) {
    extern __shared__ __attribute__((aligned(16))) unsigned char lds_raw[];
    LAS unsigned char* lds = (LAS unsigned char*)lds_raw;
    cg::grid_group grid = cg::this_grid();
#define GRID_SYNC_CG() do { asm volatile("s_waitcnt vmcnt(0)" ::: "memory"); grid.sync(); if (threadIdx.x == 0) { __builtin_amdgcn_fence(__ATOMIC_ACQUIRE, "agent"); asm volatile("s_waitcnt vmcnt(0)" ::: "memory"); } __syncthreads(); } while (0)
    volatile LAS unsigned* bst = (volatile LAS unsigned*)(lds + LDS_BYTES - 64);
    if (threadIdx.x < 16) bst[threadIdx.x] = 0u;
    __syncthreads();
    (void)xcd_barrier_post((unsigned*)(A.ws + WS_BAR), bst);
#define GRID_SYNC() do { XcdBarrier b_; b_.bar = (unsigned*)(A.ws + WS_BAR); b_.x = xb_xcc_id(); b_.st = (volatile LAS unsigned*)(lds + LDS_BYTES - 64); xcd_barrier(b_); } while (0)
    const int tid = opaque_tid(), lane = tid & 63, wid = __builtin_amdgcn_readfirstlane(tid >> 6); const int G = gridDim.x, bid = blockIdx.x;
    unsigned char* ws = A.ws;
    bf16* Y = (bf16*)(ws + WS_Y); bf16* ACT = (bf16*)(ws + WS_ACT); bf16* P = (bf16*)(ws + WS_P); bf16* MIX = (bf16*)(ws + WS_MIX); bf16* H = (bf16*)(ws + WS_H);

#ifdef DEBUG_NANFILL
    { f32x4 q; q.x = q.y = q.z = q.w = __builtin_nanf(""); f32x4* p = (f32x4*)(ws + WS_H); const size_t n = (WS_KF - WS_H) / 16; for (size_t i = (size_t)bid * NTHR + tid; i < n; i += (size_t)G * NTHR) p[i] = q; }
    GRID_SYNC();
#endif
    for (int it = bid; it < 144; it += G) mod_item(A, it, lds);
    for (int it = bid; it < 576; it += G) filter_item(A, it, lds);
    { LAS float* scr = (LAS float*)(lds + wid * 16384); const int gw = bid * NWAVES + wid, NGW = G * NWAVES;
      constexpr int I_GU = 16 * 88, I_D = 44 * 32, I_IN = 16 * 56, I_OUT = 16 * 32;
      constexpr int PER_L = 4 * I_GU + 2 * I_D + I_IN + I_OUT;
      const int share0 = (bid < 144) ? bid * 3 : 432 + (bid - 144) * 5, nshare = (bid < 144) ? 3 : 5; const bool wsplit = (G == 256);
      const int it_lo = wsplit ? share0 * 40 + wid : gw, it_hi = wsplit ? ((share0 + nshare) * 40 < DEPTH * PER_L ? (share0 + nshare) * 40 : DEPTH * PER_L) : DEPTH * PER_L, it_st = wsplit ? NWAVES : NGW;
      for (int it = it_lo; it < it_hi; it += it_st) { const int l = it / PER_L; int r = it % PER_L;
          if (r < 4 * I_GU) { const int f = r / (2 * I_GU), gu = (r / I_GU) & 1, ii = r % I_GU;
              transpose_item((gu ? A.w_up : A.w_gate) + (size_t)(l * 2 + f) * 1024 * DFF, 1024, DFF, (bf16*)(ws + WS_WGU) + (size_t)(l * 2 + f) * 5632 * 1024, gu ? 2 : 1, scr, ii, lane); continue; }
          r -= 4 * I_GU;
          if (r < 2 * I_D) { const int f = r / I_D, ii = r % I_D;
              transpose_item(A.w_down + (size_t)(l * 2 + f) * DFF * 1024, DFF, 1024, (bf16*)(ws + WS_WD) + (size_t)(l * 2 + f) * 1024 * DFF, 0, scr, ii, lane); continue; }
          r -= 2 * I_D;
          if (r < I_IN) { transpose_item(A.w_in + (size_t)l * 1024 * INW, 1024, INW, (bf16*)(ws + WS_WIN) + (size_t)l * INW * 1024, 0, scr, r, lane); continue; }
          r -= I_IN;
          transpose_item(A.w_out + (size_t)l * 1024 * 1024, 1024, 1024, (bf16*)(ws + WS_WOUT) + (size_t)l * 1024 * 1024, 0, scr, r, lane); } }
    GRID_SYNC_CG();
    for (int it = bid; it < DEPTH * 256; it += G) filter_fft_item<SEQ, 2>(A, it, lds);
    for (int it = bid; it < (DEPTH - 1) * 32; it += G) filter_fft_item<CTXL, 16>(A, it, lds);
    sb_items(A, G, lds);
    __syncthreads();
    prologue_rows(A, G);
    GRID_SYNC();

    bf16* HS = Y; float* SS = (float*)(ws + WS_SS);
#pragma unroll 1
    for (int l = 0; l < DEPTH; ++l) {
        const bool last = (l == DEPTH - 1);
        const float* modl = (const float*)(ws + WS_MOD) + (size_t)l * 9 * 9216;
        const float* SBl = (const float*)(ws + WS_SB) + (size_t)l * SB_PER_L;
#pragma unroll 1
        for (int f = 0; f < 2; ++f) {
            if (f == 1) {
                { pg8::Gemm g{HS, (const bf16*)(ws + WS_WIN) + (size_t)l * INW * 1024, MROWS, INW, 1024}; pg8::TileOrder S; S.init(MROWS, INW, G, bid, 0);
                  pg8::EpiStoreBf16 E{P, INW, SS, SBl + SB_IN}; pg8::gemm_phase<pg8::EpiStoreBf16, pg8::TileOrder, true, true>(lds, g, S, E); }
                GRID_SYNC();
                for (int it = bid; it < MROWS / 64; it += G) prep_item(A, l, it, lds);
                GRID_SYNC();
                const int vcu = (G % 8 == 0) ? (bid & 7) * (G >> 3) + (bid >> 3) : bid;
                for (int u = vcu; u < 512 + (last ? 0 : 64); u += G) {
                    const attn_body::bf16* Pb = (const attn_body::bf16*)P; attn_body::bf16* Mb = (attn_body::bf16*)MIX;
                    if (u < 512) { const int qb = u & 7, h = (u >> 3) & 7, b = u >> 6; const size_t kr = (size_t)b * RPB, qr = kr + qb * 256;
                        attn_body::attn_unit<8>(Pb + qr * INW + 1024 + h * 64, Pb + kr * INW + 1536 + (h >> 2) * 64, Pb + kr * INW + 1664 + (h >> 2) * 64, Mb + qr * 1024 + 512 + h * 64, 36, (char*)lds_raw); }
                    else { const int h = (u - 512) & 7, b = (u - 512) >> 3; const size_t kr = (size_t)b * RPB + SEQ;
                        attn_body::attn_unit<8>(Pb + kr * INW + 1024 + h * 64, Pb + kr * INW + 1536 + (h >> 2) * 64, Pb + kr * INW + 1664 + (h >> 2) * 64, Mb + kr * 1024 + 512 + h * 64, 4, (char*)lds_raw); }
                }
                __syncthreads();
                for (int it = bid; it < 512; it += G) hyena_item<SEQ, 2>(A, l, it, lds);
                if (!last) for (int it = bid; it < 64; it += G) hyena_item<CTXL, 16>(A, l, it, lds);
                GRID_SYNC();
                { pg8::Gemm g{MIX, (const bf16*)(ws + WS_WOUT) + (size_t)l * 1024 * 1024, MROWS, 1024, 1024}; pg8::TileOrder S; S.init(MROWS, 1024, G, bid, last ? 1 : 0);
                  pg8::EpiResid<false> E{H, modl, nullptr, 5, HS, A.norm_g + ((size_t)l * 3 + 2) * 1024, modl, 7, SS, nullptr}; pg8::gemm_phase<pg8::EpiResid<false>, pg8::TileOrder, true, true>(lds, g, S, E); }
                GRID_SYNC();
            }
            { pg8::Gemm g{HS, (const bf16*)(ws + WS_WGU) + (size_t)(l * 2 + f) * 5632 * 1024, MROWS, 5632, 1024}; pg8::TileOrder S; S.init(MROWS, 5632, G, bid, (last && f == 1) ? 1 : 0);
              pg8::EpiSwiGLU E{ACT, SS, SBl + (f ? SB_G2 : 0)}; pg8::gemm_phase<pg8::EpiSwiGLU, pg8::TileOrder, true, true>(lds, g, S, E); }
            GRID_SYNC();
            { pg8::Gemm g{ACT, (const bf16*)(ws + WS_WD) + (size_t)(l * 2 + f) * 1024 * DFF, MROWS, 1024, DFF}; pg8::TileOrder S; S.init(MROWS, 1024, G, bid, (last && f == 1) ? 1 : 2);
              const int ln = f ? (last ? l : l + 1) : l;
              const float* gn = A.norm_g + ((size_t)ln * 3 + (f ? 0 : 1)) * 1024; const float* mn = (const float*)(ws + WS_MOD) + (size_t)ln * 9 * 9216;
              pg8::EpiResid<true> E{H, modl, (last && f == 1) ? A.out : nullptr, f ? 8 : 2, HS, gn, mn, f ? 1 : 4, SS, (float*)(ws + WS_P)};
              pg8::gemm_phase<pg8::EpiResid<true>, pg8::TileOrder, true, true>(lds, g, S, E);
              if (!(last && f == 1)) { GRID_SYNC(); ctx_finalize(A, modl, f ? 8 : 2, gn, mn, f ? 1 : 4, G); GRID_SYNC(); } }
        }
    }
}

extern "C" void kernel_launch(void* const* d_in, const int* in_sizes, int n_in, void* d_out, int out_size, void* d_ws, size_t ws_size, hipStream_t stream) {
    static int grid = 0;
    if (grid == 0) {
        if (n_in != 25 || ws_size < WS_END) { fprintf(stderr, "kernel_launch: expected 25 inputs and >= %zu bytes of workspace; got %d, %zu\n", (size_t)WS_END, n_in, ws_size); grid = -1; return; }
        int dev = 0, cus = 0, per_cu = 0;
        hipGetDevice(&dev); hipDeviceGetAttribute(&cus, hipDeviceAttributeMultiprocessorCount, dev);
        if (hipFuncSetAttribute((const void*)fwd_megakernel, hipFuncAttributeMaxDynamicSharedMemorySize, LDS_BYTES) != hipSuccess) { fprintf(stderr, "kernel_launch: hipFuncSetAttribute failed\n"); grid = -1; return; }
        if (hipOccupancyMaxActiveBlocksPerMultiprocessor(&per_cu, (const void*)fwd_megakernel, NTHR, LDS_BYTES) != hipSuccess || per_cu < 1) { fprintf(stderr, "kernel_launch: occupancy query gave %d\n", per_cu); per_cu = 1; }
        (void)hipGetLastError();
        grid = cus * 1;
    }
    if (grid < 0) return;
    if (hipMemsetAsync((char*)d_ws + WS_BAR, 0, WS_BAR_BYTES, stream) != hipSuccess) { fprintf(stderr, "kernel_launch: memset failed\n"); return; }
    Args a{};
    const float** ap = (const float**)&a;
    for (int i = 0; i < 25; ++i) ap[i] = (const float*)d_in[i];
    a.out = (float*)d_out; a.ws = (unsigned char*)d_ws;
    void* args[] = {&a};
    hipError_t e = hipLaunchCooperativeKernel((const void*)fwd_megakernel, dim3(grid), dim3(NTHR), args, LDS_BYTES, stream);
    if (e != hipSuccess) fprintf(stderr, "cooperative launch failed: %s (grid %d)\n", hipGetErrorString(e), grid);
}
```

```cpp
#include <hip/hip_runtime.h>
#include <hip/hip_cooperative_groups.h>
#include <hip/hip_bf16.h>
#include <cstdio>
#include <cstdint>
#include <cmath>
namespace cg = cooperative_groups;
__device__ __forceinline__ int opaque_tid() { int t = threadIdx.x; asm volatile("" : "+v"(t)); return t; }
namespace pg8 {
#define PG8_LAS __attribute__((address_space(3)))
typedef unsigned short bf16_t;
typedef short bf16x8 __attribute__((ext_vector_type(8)));
typedef float f32x4 __attribute__((ext_vector_type(4)));
typedef unsigned u32x4 __attribute__((ext_vector_type(4)));
constexpr int BM = 256, BK = 64, HALF = 128, HTB = HALF * BK * 2  , STAGE_BYTES = 8 * HTB, NXCD = 8, WGM = 8;

__host__ __device__ __forceinline__ int lds_byte(int r, int c) { const int st = (r >> 4) * 2 + (c >> 5), rr = r & 15, cc = c & 31, ob = rr * 64 + cc * 2; return st * 1024 + (ob ^ (((ob >> 9) & 1) << 5)); }
__host__ __device__ __forceinline__ void stage_rc(int b, int& R, int& C) { const int st = b / 1024, sb = b % 1024, swz = sb ^ (((sb >> 9) & 1) << 5); R = (st >> 1) * 16 + swz / 64; C = (st & 1) * 32 + (swz % 64) / 2; }
__host__ __device__ __forceinline__ int perm32(int rho) { const int n = rho >> 4, i = rho & 15; return 8 * (i >> 2) + 4 * n + (i & 3); }

struct Unit { int pm, pn, ko, nt; };
struct Gemm { const bf16_t* A; const bf16_t* Bt; int M, N, K; };

struct StaticOrder {
    int nM, nN, nwg, G, c;
    __host__ __device__ void init(int M, int N, int G_, int c_) { nM = M / BM; nN = N / BM; nwg = nM * nN; G = G_; c = c_; }
    __host__ __device__ bool next(int i, Unit& u) const {
        const long L = (long)i * G + c; if (L >= nwg) return false;
        int wgid = (int)L; { const int q = nwg / NXCD, r = nwg % NXCD, xcd = wgid % NXCD, off = wgid / NXCD; wgid = (xcd < r ? xcd * (q + 1) : r * (q + 1) + (xcd - r) * q) + off; }
        const int nig = WGM * nN, gid = wgid / nig, fm = gid * WGM, gsz = (nM - fm) < WGM ? (nM - fm) : WGM;
        u.pm = fm + ((wgid % nig) % gsz); u.pn = (wgid % nig) / gsz; u.ko = 0; u.nt = 0; return true;
    }
    __device__ __forceinline__ void a_ready(const Unit&) const {}
    __device__ __forceinline__ void done(const Unit&) const {}
};

__device__ __forceinline__ unsigned cvt_pk_bf16(float lo, float hi) { unsigned r; asm volatile("v_cvt_pk_bf16_f32 %0, %1, %2" : "=v"(r) : "v"(lo), "v"(hi)); return r; }
typedef unsigned u32x2 __attribute__((ext_vector_type(2)));
__device__ __forceinline__ int mod_batch(int pm) { return (pm % 9 == 8) ? 8 : pm / 9; }
__device__ __forceinline__ float sum_fq(float s) {
    { auto rr = __builtin_amdgcn_permlane16_swap(__float_as_uint(s), __float_as_uint(s), false, false); s = __uint_as_float(rr[0]) + __uint_as_float(rr[1]); }
    { auto rr = __builtin_amdgcn_permlane32_swap(__float_as_uint(s), __float_as_uint(s), false, false); s = __uint_as_float(rr[0]) + __uint_as_float(rr[1]); }
    return s;
}
__device__ __forceinline__ void load_rstd(float (&rs)[2][4], const float* SS, const Unit& u, int wr, int fr, int fq) {
    f32x4 p[2][4];
#pragma unroll
    for (int ai = 0; ai < 2; ++ai)
#pragma unroll
        for (int m = 0; m < 4; ++m) p[ai][m] = *(const f32x4*)(SS + (size_t)(u.pm * BM + wr * 64 + fr + ai * HALF + m * 16) * 16 + 4 * fq);
#pragma unroll
    for (int ai = 0; ai < 2; ++ai)
#pragma unroll
        for (int m = 0; m < 4; ++m) { const f32x4 a = p[ai][m]; const float s = sum_fq((a[0] + a[1]) + (a[2] + a[3]));
            rs[ai][m] = __builtin_amdgcn_rsqf(s * (1.0f / 1024.0f) + 1e-6f); }
}
struct EpiSwiGLU {
    static constexpr bool PERM = true, AFTER_DRAIN = false;
    bf16_t* O; const float* SS; const float* sb;
    __device__ __forceinline__ void operator()(const f32x4 (&acc)[2][2][4][2], const Unit& u, int wr, int wc, int fr, int fq) const {
        const int row0 = u.pm * BM + wr * 64 + fr, f0 = u.pn * 128 + wc * 32 + 8 * fq;
        float rs[2][4]; load_rstd(rs, SS, u, wr, fr, fq);
        const float* sbp = sb + (size_t)mod_batch(u.pm) * 5632 + u.pn * BM + wc * 32 + 8 * fq;
        f32x4 bv[2][2];
#pragma unroll
        for (int bj = 0; bj < 2; ++bj)
#pragma unroll
            for (int n = 0; n < 2; ++n) bv[bj][n] = *(const f32x4*)(sbp + bj * HALF + 4 * n);
#pragma unroll
        for (int ai = 0; ai < 2; ++ai)
#pragma unroll
            for (int m = 0; m < 4; ++m) { bf16_t* rowp = O + (size_t)(row0 + ai * HALF + m * 16) * 2816 + f0; const float r = rs[ai][m];
                const f32x4 g0 = acc[ai][0][m][0] * r + bv[0][0], g1 = acc[ai][0][m][1] * r + bv[0][1], u0 = acc[ai][1][m][0] * r + bv[1][0], u1 = acc[ai][1][m][1] * r + bv[1][1];
                const f32x4 a0 = g0 * -1.4426950408889634f, a1 = g1 * -1.4426950408889634f; f32x4 e0, e1;
#pragma unroll
                for (int j = 0; j < 4; ++j) { e0[j] = __builtin_amdgcn_exp2f(a0[j]); e1[j] = __builtin_amdgcn_exp2f(a1[j]); }
                e0 = e0 + 1.0f; e1 = e1 + 1.0f;
#pragma unroll
                for (int j = 0; j < 4; ++j) { e0[j] = __builtin_amdgcn_rcpf(e0[j]); e1[j] = __builtin_amdgcn_rcpf(e1[j]); }
                const f32x4 v0 = (g0 * u0) * e0, v1 = (g1 * u1) * e1;
                typedef float f2_t __attribute__((ext_vector_type(2))); typedef __bf16 b2_t __attribute__((ext_vector_type(2)));
                u32x4 w;
                w.x = __builtin_bit_cast(unsigned, __builtin_convertvector((f2_t){v0[0], v0[1]}, b2_t)); w.y = __builtin_bit_cast(unsigned, __builtin_convertvector((f2_t){v0[2], v0[3]}, b2_t));
                w.z = __builtin_bit_cast(unsigned, __builtin_convertvector((f2_t){v1[0], v1[1]}, b2_t)); w.w = __builtin_bit_cast(unsigned, __builtin_convertvector((f2_t){v1[2], v1[3]}, b2_t));
                *(u32x4*)(rowp) = w; }
    }
};
template <bool HALFSTEP> struct EpiResid {
    static constexpr bool PERM = true, AFTER_DRAIN = false;
    bf16_t* H; const float* modl; float* out; int gate_idx;
    bf16_t* HS; const float* g_next; const float* mod_next; int scale_idx; float* SS;
    float* part;
    __device__ __forceinline__ void operator()(const f32x4 (&acc)[2][2][4][2], const Unit& u, int wr, int wc, int fr, int fq) const {
        const int row0 = u.pm * BM + wr * 64 + fr, col0 = u.pn * BM + wc * 32 + 8 * fq; const int mb = mod_batch(u.pm);
        if (u.nt != 0) { const int sl = (u.ko < 2048) ? (u.ko >> 9) : (u.ko == 2048 ? 4 : 5);     float* pp = part + ((size_t)sl * 2048 + (u.pm / 9) * 256 + wr * 64 + fr) * 1024 + col0;
#pragma unroll
            for (int ai = 0; ai < 2; ++ai)
#pragma unroll
                for (int m = 0; m < 4; ++m)
#pragma unroll
                    for (int bj = 0; bj < 2; ++bj)
#pragma unroll
                        for (int n = 0; n < 2; ++n) *(f32x4*)(pp + (size_t)(ai * HALF + m * 16) * 1024 + bj * HALF + 4 * n) = acc[ai][bj][m][n];
            return; }
        const float* coef = modl + ((size_t)mb * 9 + gate_idx) * 1024 + col0;
        f32x4 cv[2][2];
#pragma unroll
        for (int bj = 0; bj < 2; ++bj)
#pragma unroll
            for (int n = 0; n < 2; ++n) cv[bj][n] = *(const f32x4*)(coef + bj * HALF + 4 * n) * (HALFSTEP ? 0.5f : 1.0f);
        const int jt = u.pm % 9, bb = u.pm / 9;
        f32x4 v[2][2][4][2];
#pragma unroll
        for (int a_ = 0; a_ < 2; ++a_)
#pragma unroll
            for (int b_ = 0; b_ < 2; ++b_)
#pragma unroll
                for (int m_ = 0; m_ < 4; ++m_)
#pragma unroll
                    for (int n_ = 0; n_ < 2; ++n_) v[a_][b_][m_][n_] = acc[a_][b_][m_][n_];
        u32x4 t[4][2];
#define LDROW(buf, c) do { const bf16_t* rowp = H + (size_t)(u.pm * BM + wr * 64 + fr + ((c) >> 2) * HALF + ((c) & 3) * 16) * 1024 + col0; \
            _Pragma("unroll") for (int bj = 0; bj < 2; ++bj) t[buf][bj] = *(const u32x4*)(rowp + bj * HALF); } while (0)
#define FOLDROW(buf, c) do { _Pragma("unroll") for (int bj = 0; bj < 2; ++bj) { const u32x4 r_ = t[buf][bj]; f32x4 o0_, o1_; \
              o0_[0] = __builtin_bit_cast(float, r_.x << 16); o0_[1] = __builtin_bit_cast(float, r_.x & 0xffff0000u); o0_[2] = __builtin_bit_cast(float, r_.y << 16); o0_[3] = __builtin_bit_cast(float, r_.y & 0xffff0000u); \
              o1_[0] = __builtin_bit_cast(float, r_.z << 16); o1_[1] = __builtin_bit_cast(float, r_.z & 0xffff0000u); o1_[2] = __builtin_bit_cast(float, r_.w << 16); o1_[3] = __builtin_bit_cast(float, r_.w & 0xffff0000u); \
              v[(c) >> 2][bj][(c) & 3][0] = o0_ + cv[bj][0] * v[(c) >> 2][bj][(c) & 3][0]; asm volatile("" : "+v"(v[(c) >> 2][bj][(c) & 3][0])); \
              v[(c) >> 2][bj][(c) & 3][1] = o1_ + cv[bj][1] * v[(c) >> 2][bj][(c) & 3][1]; asm volatile("" : "+v"(v[(c) >> 2][bj][(c) & 3][1])); } } while (0)
#define CHUNK_FENCE() do { asm volatile("" ::: "memory"); __builtin_amdgcn_sched_barrier(0); } while (0)
        LDROW(0, 0); LDROW(1, 1); LDROW(2, 2); LDROW(3, 3); CHUNK_FENCE();
        FOLDROW(0, 0); CHUNK_FENCE(); FOLDROW(1, 1); CHUNK_FENCE(); LDROW(0, 4); LDROW(1, 5); CHUNK_FENCE();
        FOLDROW(2, 2); CHUNK_FENCE(); FOLDROW(3, 3); CHUNK_FENCE(); LDROW(2, 6); LDROW(3, 7); CHUNK_FENCE();
        FOLDROW(0, 4); CHUNK_FENCE(); FOLDROW(1, 5); CHUNK_FENCE(); FOLDROW(2, 6); CHUNK_FENCE(); FOLDROW(3, 7); CHUNK_FENCE();
#undef LDROW
#undef FOLDROW
        f32x4 gs[2][2];
#pragma unroll
        for (int bj = 0; bj < 2; ++bj)
#pragma unroll
            for (int n = 0; n < 2; ++n) gs[bj][n] = *(const f32x4*)(g_next + col0 + bj * HALF + 4 * n) * (1.0f + *(const f32x4*)(mod_next + ((size_t)mb * 9 + scale_idx) * 1024 + col0 + bj * HALF + 4 * n));
        CHUNK_FENCE();
#undef CHUNK_FENCE
#pragma unroll
        for (int ai = 0; ai < 2; ++ai)
#pragma unroll
            for (int m = 0; m < 4; ++m) { const int rr = wr * 64 + fr + ai * HALF + m * 16; const size_t grow = (size_t)(u.pm * BM + rr); bf16_t* rowp = H + grow * 1024 + col0;
                float* orow = (out != nullptr && jt < 8) ? out + ((size_t)bb * 2048 + jt * 256 + rr) * 1024 + col0 : nullptr; float ssq = 0.f;
#pragma unroll
                for (int bj = 0; bj < 2; ++bj) { const f32x4 x0 = v[ai][bj][m][0], x1 = v[ai][bj][m][1];
                    { u32x4 hw; hw.x = cvt_pk_bf16(x0[0], x0[1]); hw.y = cvt_pk_bf16(x0[2], x0[3]); hw.z = cvt_pk_bf16(x1[0], x1[1]); hw.w = cvt_pk_bf16(x1[2], x1[3]); *(u32x4*)(rowp + bj * HALF) = hw; }
                    if (orow) { *(f32x4*)(orow + bj * HALF) = x0; *(f32x4*)(orow + bj * HALF + 4) = x1; }
                    { const f32x4 h0 = x0 * gs[bj][0], h1 = x1 * gs[bj][1]; u32x4 w; w.x = cvt_pk_bf16(h0[0], h0[1]); w.y = cvt_pk_bf16(h0[2], h0[3]); w.z = cvt_pk_bf16(h1[0], h1[1]); w.w = cvt_pk_bf16(h1[2], h1[3]);
                      *(u32x4*)(HS + grow * 1024 + col0 + bj * HALF) = w; }
                    ssq += ((x0[0] * x0[0] + x0[1] * x0[1]) + (x0[2] * x0[2] + x0[3] * x0[3])) + ((x1[0] * x1[0] + x1[1] * x1[1]) + (x1[2] * x1[2] + x1[3] * x1[3])); }
                { ssq = sum_fq(ssq); if (fq == 0) SS[grow * 16 + u.pn * 4 + wc] = ssq; } }
    }
};
struct EpiStoreBf16 {
    static constexpr bool PERM = true, AFTER_DRAIN = false;
    bf16_t* O; int ldc; const float* SS; const float* sb;
    __device__ __forceinline__ void operator()(const f32x4 (&acc)[2][2][4][2], const Unit& u, int wr, int wc, int fr, int fq) const {
        const int row0 = u.pm * BM + wr * 64 + fr, col0 = u.pn * BM + wc * 32 + 8 * fq;
        float rs[2][4]; load_rstd(rs, SS, u, wr, fr, fq);
        const float* sbp = sb + (size_t)mod_batch(u.pm) * ldc + col0;
        f32x4 bv[2][2];
#pragma unroll
        for (int bj = 0; bj < 2; ++bj)
#pragma unroll
            for (int n = 0; n < 2; ++n) bv[bj][n] = *(const f32x4*)(sbp + bj * HALF + 4 * n);
#pragma unroll
        for (int ai = 0; ai < 2; ++ai)
#pragma unroll
            for (int m = 0; m < 4; ++m) { bf16_t* rowp = O + (size_t)(row0 + ai * HALF + m * 16) * ldc + col0; const float r = rs[ai][m];
#pragma unroll
                for (int bj = 0; bj < 2; ++bj) { const f32x4 v0 = acc[ai][bj][m][0] * r + bv[bj][0], v1 = acc[ai][bj][m][1] * r + bv[bj][1];
                    u32x4 w; w.x = cvt_pk_bf16(v0[0], v0[1]); w.y = cvt_pk_bf16(v0[2], v0[3]); w.z = cvt_pk_bf16(v1[0], v1[1]); w.w = cvt_pk_bf16(v1[2], v1[3]);
                    *(u32x4*)(rowp + bj * HALF) = w; } }
    }
};
struct TileOrder {
    StaticOrder so; int mode, nN, G, c;
    __device__ __forceinline__ void init(int M, int N, int G_, int c_, int mode_) { so.init(M, N, G_, c_); mode = mode_; nN = N / BM; G = G_; c = c_; }
    __device__ __forceinline__ bool next(int i, Unit& u) const {
        if (mode == 0) return so.next(i, u);
        const int L = i * G + c;
        if (mode == 1) { if (L >= 64 * nN) return false; const int xcd = L & 7, q = L >> 3; u.pm = xcd * 9 + (q & 7); u.pn = q >> 3; u.ko = 0; u.nt = 0; return true; }
        if (L < 256) { const int xcd = L & 7, s = L >> 3; u.pm = xcd * 9 + (s >> 2); u.pn = s & 3; u.ko = 0; u.nt = 0; return true; }
        const int r = L - 256; if (r >= 192) return false;
        const int xcd = r & 7, s = r >> 3, sl = s % 6; u.pm = xcd * 9 + 8; u.pn = s / 6;
        u.ko = (sl < 4) ? sl * 512 : (sl == 4 ? 2048 : 2432); u.nt = (sl < 4) ? 8 : 6; return true;
    }
    __device__ __forceinline__ void a_ready(const Unit&) const {}
    __device__ __forceinline__ void done(const Unit&) const {}
};
template <class Epi, class Sched, bool ALIGN_EPI = false, bool SP2 = false>
__device__ __forceinline__ void gemm_phase(PG8_LAS unsigned char* lds, const Gemm g, const Sched& S, const Epi& E) {
    const int tid = opaque_tid(), wid = __builtin_amdgcn_readfirstlane(tid >> 6), lane = tid & 63, wr = wid >> 2, wc = wid & 3, fr = lane & 15, fq = lane >> 4;
    const int K = g.K, nt = K / BK;
    unsigned voffA[2], voffB[2];
#pragma unroll
    for (int i = 0; i < 2; ++i) { int R, C; stage_rc(tid * 16 + i * 8192, R, C); const int Rb = Epi::PERM ? ((R & ~31) + perm32(R & 31)) : R;
        voffA[i] = (unsigned)(R * K + C) * 2u; voffB[i] = (unsigned)(Rb * K + C) * 2u; }
    const size_t kstep = (size_t)(BK * 2);
    const size_t hstep = (size_t)HALF * K * 2;
    const size_t tstep = 2 * hstep;
    const unsigned ldsw = (unsigned)wid * 1024u;
    const int aoff = lds_byte(wr * 64 + fr, fq * 8), boff = lds_byte(wc * 32 + fr, fq * 8);
#define PG8_SA(b, h) (((b) * 2 + (h)) * HTB)
#define PG8_SB(b, h) ((4 + (b) * 2 + (h)) * HTB)
#define PG8_STAGE(bufoff, gbase, voff) do { _Pragma("unroll") for (int _i = 0; _i < 2; ++_i) \
        __builtin_amdgcn_global_load_lds((const unsigned*)((const char*)(gbase) + (voff)[_i]), (PG8_LAS unsigned*)(lds + (bufoff) + ldsw + _i * 8192), 16, 0, 0); } while (0)
#define PG8_LDA(dst, b, h) do { _Pragma("unroll") for (int m = 0; m < 4; ++m) _Pragma("unroll") for (int k = 0; k < 2; ++k) dst[m][k] = *(const PG8_LAS bf16x8*)(lds + PG8_SA(b, h) + aoff + m * 2048 + k * 1024); } while (0)
#define PG8_LDB(dst, b, h) do { _Pragma("unroll") for (int n = 0; n < 2; ++n) _Pragma("unroll") for (int k = 0; k < 2; ++k) dst[n][k] = *(const PG8_LAS bf16x8*)(lds + PG8_SB(b, h) + boff + n * 2048 + k * 1024); } while (0)
#define PG8_MMA(ai, bj, At, Bt) do { __builtin_amdgcn_s_setprio(1); _Pragma("unroll") for (int m = 0; m < 4; ++m) _Pragma("unroll") for (int n = 0; n < 2; ++n) _Pragma("unroll") for (int k = 0; k < 2; ++k) \
        acc[ai][bj][m][n] = __builtin_amdgcn_mfma_f32_16x16x32_bf16(Bt[n][k], At[m][k], acc[ai][bj][m][n], 0, 0, 0); __builtin_amdgcn_s_setprio(0); } while (0)
#define PG8_WAIT_V(n) asm volatile("s_waitcnt vmcnt(" #n ")" ::: "memory")
#define PG8_WAIT_L(n) asm volatile("s_waitcnt lgkmcnt(" #n ")" ::: "memory")
#define PG8_BAR __builtin_amdgcn_s_barrier()
#define PG8_SCHED __builtin_amdgcn_sched_barrier(0)
    Unit cur, nxt; int ui = 0;
    if (!S.next(0, cur)) return;
    f32x4 acc[2][2][4][2];
#pragma unroll
    for (int a = 0; a < 2; ++a)
#pragma unroll
        for (int b = 0; b < 2; ++b)
#pragma unroll
            for (int m = 0; m < 4; ++m)
#pragma unroll
                for (int n = 0; n < 2; ++n) acc[a][b][m][n] = (f32x4){0.f, 0.f, 0.f, 0.f};
    bf16x8 At[4][2], B0[2][2], B1[2][2];
    const char* cA = (const char*)g.A + (size_t)cur.pm * tstep + (size_t)cur.ko * 2; const char* cB = (const char*)g.Bt + (size_t)cur.pn * tstep + (size_t)cur.ko * 2;
    int unt = cur.nt ? cur.nt : nt;
    S.a_ready(cur);
    if constexpr (SP2) {
        PG8_STAGE(PG8_SB(0, 0), cB, voffB); PG8_STAGE(PG8_SB(0, 1), cB + hstep, voffB); PG8_STAGE(PG8_SA(0, 0), cA, voffA); PG8_STAGE(PG8_SA(0, 1), cA + hstep, voffA);
        if (wr == 1) PG8_BAR;
        PG8_WAIT_V(2); PG8_BAR;
        PG8_STAGE(PG8_SB(1, 0), cB + kstep, voffB); PG8_STAGE(PG8_SA(1, 0), cA + kstep, voffA); PG8_STAGE(PG8_SB(1, 1), cB + hstep + kstep, voffB);
        PG8_WAIT_V(6); PG8_BAR;
    } else {
        PG8_STAGE(PG8_SB(0, 0), cB, voffB); PG8_STAGE(PG8_SA(0, 0), cA, voffA); PG8_STAGE(PG8_SB(0, 1), cB + hstep, voffB); PG8_STAGE(PG8_SA(0, 1), cA + hstep, voffA);
        if (wr == 1) PG8_BAR;
        PG8_WAIT_V(4); PG8_BAR;
        PG8_STAGE(PG8_SB(1, 0), cB + kstep, voffB); PG8_STAGE(PG8_SA(1, 0), cA + kstep, voffA); PG8_STAGE(PG8_SB(1, 1), cB + hstep + kstep, voffB);
        PG8_WAIT_V(6); PG8_BAR;
    }
    for (;;) {
        const bool has_next = S.next(ui + 1, nxt);
        const char* nA = has_next ? (const char*)g.A + (size_t)nxt.pm * tstep + (size_t)nxt.ko * 2 : cA; const char* nB = has_next ? (const char*)g.Bt + (size_t)nxt.pn * tstep + (size_t)nxt.ko * 2 : cB;
        for (int t = 0; t < unt; t += 2) {
            const bool last = (t == unt - 2);
            const char* a1 = cA + (size_t)(t + 1) * kstep;
            const char* a2 = last ? nA : cA + (size_t)(t + 2) * kstep; const char* b2 = last ? nB : cB + (size_t)(t + 2) * kstep;
            const char* a3 = a2 + kstep; const char* b3 = b2 + kstep;
            if (last && has_next) S.a_ready(nxt);
            if constexpr (SP2) {
            PG8_LDB(B0, 0, 0); PG8_LDB(B1, 0, 1); PG8_SCHED; PG8_LDA(At, 0, 0); PG8_STAGE(PG8_SA(1, 1), a1 + hstep, voffA);
            PG8_WAIT_V(8); PG8_WAIT_L(0); PG8_BAR; PG8_MMA(0, 0, At, B0); PG8_MMA(0, 1, At, B1); PG8_BAR; PG8_SCHED;
            PG8_LDA(At, 0, 1); PG8_STAGE(PG8_SB(0, 0), b2, voffB); PG8_STAGE(PG8_SB(0, 1), b2 + hstep, voffB); PG8_STAGE(PG8_SA(0, 0), a2, voffA);
            PG8_WAIT_V(8); PG8_WAIT_L(0); PG8_BAR; PG8_MMA(1, 0, At, B0); PG8_MMA(1, 1, At, B1); PG8_BAR; PG8_SCHED;
            PG8_LDB(B0, 1, 0); PG8_LDB(B1, 1, 1); PG8_SCHED; PG8_LDA(At, 1, 0); PG8_STAGE(PG8_SA(0, 1), a2 + hstep, voffA);
            PG8_WAIT_V(8); PG8_WAIT_L(0); PG8_BAR; PG8_MMA(0, 0, At, B0); PG8_MMA(0, 1, At, B1); PG8_BAR; PG8_SCHED;
            PG8_LDA(At, 1, 1); PG8_STAGE(PG8_SB(1, 0), b3, voffB); PG8_STAGE(PG8_SB(1, 1), b3 + hstep, voffB); PG8_STAGE(PG8_SA(1, 0), a3, voffA);
            PG8_WAIT_V(8); PG8_WAIT_L(0); PG8_BAR; PG8_MMA(1, 0, At, B0); PG8_MMA(1, 1, At, B1); PG8_BAR; PG8_SCHED;
            } else {
            PG8_LDB(B0, 0, 0); PG8_SCHED; PG8_LDA(At, 0, 0); PG8_STAGE(PG8_SA(1, 1), a1 + hstep, voffA);
            PG8_WAIT_L(8); PG8_BAR; PG8_WAIT_L(0); PG8_MMA(0, 0, At, B0); PG8_BAR; PG8_SCHED;
            PG8_LDB(B1, 0, 1); PG8_STAGE(PG8_SB(0, 0), b2, voffB);
            PG8_BAR; PG8_WAIT_L(0); PG8_MMA(0, 1, At, B1); PG8_BAR;
            PG8_LDA(At, 0, 1); PG8_STAGE(PG8_SA(0, 0), a2, voffA);
            PG8_BAR; PG8_WAIT_L(0); PG8_MMA(1, 0, At, B0); PG8_BAR; PG8_SCHED;
            PG8_STAGE(PG8_SB(0, 1), b2 + hstep, voffB);
            PG8_WAIT_V(6); PG8_BAR; PG8_MMA(1, 1, At, B1); PG8_BAR;
            PG8_LDB(B0, 1, 0); PG8_SCHED; PG8_LDA(At, 1, 0); PG8_STAGE(PG8_SA(0, 1), a2 + hstep, voffA);
            PG8_WAIT_L(8); PG8_BAR; PG8_WAIT_L(0); PG8_MMA(0, 0, At, B0); PG8_BAR; PG8_SCHED;
            PG8_LDB(B1, 1, 1); PG8_STAGE(PG8_SB(1, 0), b3, voffB);
            PG8_BAR; PG8_WAIT_L(0); PG8_MMA(0, 1, At, B1); PG8_BAR;
            PG8_LDA(At, 1, 1); PG8_STAGE(PG8_SA(1, 0), a3, voffA);
            PG8_BAR; PG8_WAIT_L(0); PG8_MMA(1, 0, At, B0); PG8_BAR; PG8_SCHED;
            PG8_STAGE(PG8_SB(1, 1), b3 + hstep, voffB);
            PG8_WAIT_V(6); PG8_BAR; PG8_MMA(1, 1, At, B1); PG8_BAR;
            }
        }
        if constexpr (ALIGN_EPI) { if (wr == 0) PG8_BAR; }
        if constexpr (!Epi::AFTER_DRAIN) { E(acc, cur, wr, wc, fr, fq); S.done(cur); }
        if (!has_next) break;
#pragma unroll
        for (int a = 0; a < 2; ++a)
#pragma unroll
            for (int b = 0; b < 2; ++b)
#pragma unroll
                for (int m = 0; m < 4; ++m)
#pragma unroll
                    for (int n = 0; n < 2; ++n) acc[a][b][m][n] = (f32x4){0.f, 0.f, 0.f, 0.f};
        cur = nxt; cA = nA; cB = nB; ++ui; unt = cur.nt ? cur.nt : nt;
        if constexpr (ALIGN_EPI) { if (wr == 1) PG8_BAR; }
    }
    PG8_WAIT_V(0);
    if constexpr (!ALIGN_EPI) { if (wr == 0) PG8_BAR; }
    PG8_BAR;
    if constexpr (Epi::AFTER_DRAIN) { E.fused(acc, cur, wr, wc, fr, fq, lds, wid, lane); S.done(cur); }
#undef PG8_SA
#undef PG8_SB
#undef PG8_STAGE
#undef PG8_LDA
#undef PG8_LDB
#undef PG8_MMA
#undef PG8_WAIT_V
#undef PG8_WAIT_L
#undef PG8_BAR
#undef PG8_SCHED
}
}
namespace attn_body {
using bf16=__hip_bfloat16;
using bf16x8=__attribute__((ext_vector_type(8)))short;
using s16x4=__attribute__((ext_vector_type(4)))short;
using f32x16=__attribute__((ext_vector_type(16)))float;
using u32x4=__attribute__((ext_vector_type(4)))unsigned;
constexpr int D=64,DM=1792,DMO=1024;
constexpr int NW=8,QBLK=32,QB=QBLK*NW,KVBLK=64;
__device__ __forceinline__ int crow(int r,int hi){return (r&3)+8*(r>>2)+4*hi;}
#define SBAR() __builtin_amdgcn_sched_barrier(0)
__device__ __forceinline__ void cmask(f32x16&p0,f32x16&p1,int jb,int qrel,int hi){
  const float NEG=-INFINITY; int kb=64*jb+4*hi;
  #pragma unroll
  for(int r=0;r<16;++r){int kv=kb+(r&3)+8*(r>>2); if(kv>qrel)p0[r]=NEG; if(kv+32>qrel)p1[r]=NEG;}
}

constexpr int NSLOT=3, SLOTB=8192;
constexpr int LDS_K=0, LDS_V=NSLOT*SLOTB, LDS_WS=2*NSLOT*SLOTB, LDS_OST=LDS_WS+NW*64*4, LDS_BYTES=LDS_OST+NW*4096;
constexpr float C2=0.125f*1.4426950408889634f;
__device__ __forceinline__ void glds16(const void*gsrc,unsigned lds_dst){unsigned keep;
  asm volatile("s_mov_b32 %0, m0\n\ts_mov_b32 m0, %2\n\ts_nop 0\n\tglobal_load_lds_dwordx4 %1, off\n\ts_mov_b32 m0, %0":"=&s"(keep):"v"(gsrc),"s"(lds_dst):"memory");}
__device__ __forceinline__ float max3f(float a,float b,float c){float r;asm("v_max3_f32 %0, %1, %2, %3":"=v"(r):"v"(a),"v"(b),"v"(c));return r;}
__device__ __forceinline__ float max2f(float a,float b){float r;asm("v_max_f32_e32 %0, %1, %2":"=v"(r):"v"(a),"v"(b));return r;}
__device__ __forceinline__ float fadd_s(float a,float b){float r;asm("v_add_f32_e32 %0, %1, %2":"=v"(r):"v"(a),"v"(b));return r;}
__device__ __forceinline__ float fsub_s(float a,float b){float r;asm("v_sub_f32_e32 %0, %1, %2":"=v"(r):"v"(a),"v"(b));return r;}
typedef float f32x2_t __attribute__((ext_vector_type(2))); typedef __bf16 bf16x2_t __attribute__((ext_vector_type(2)));
__device__ __forceinline__ unsigned cvtpk_s(float lo,float hi){f32x2_t v={lo,hi};bf16x2_t b=__builtin_convertvector(v,bf16x2_t);return __builtin_bit_cast(unsigned,b);}
#define WAIT_BAR(N) asm volatile("s_waitcnt vmcnt(" #N ") lgkmcnt(0)\n\ts_barrier":::"memory")

__device__ __forceinline__ void qkt(f32x16&p0,f32x16&p1,const char*Kslot,const bf16x8*qr,const f32x16&negm,int r32,int hi){
  const char*kb=Kslot+hi*1024+r32*16;
  #pragma unroll
  for(int d0=0;d0<4;++d0){
    const bf16x8 b0=*reinterpret_cast<const bf16x8*>(kb+d0*2048);
    const bf16x8 b1=*reinterpret_cast<const bf16x8*>(kb+d0*2048+512);
    if(d0==0){p0=__builtin_amdgcn_mfma_f32_32x32x16_bf16(b0,qr[0],negm,0,0,0);p1=__builtin_amdgcn_mfma_f32_32x32x16_bf16(b1,qr[0],negm,0,0,0);}
    else{p0=__builtin_amdgcn_mfma_f32_32x32x16_bf16(b0,qr[d0],p0,0,0,0);p1=__builtin_amdgcn_mfma_f32_32x32x16_bf16(b1,qr[d0],p1,0,0,0);}}
}
typedef __attribute__((address_space(3))) const char* lds_cptr;
typedef short v4i16_t __attribute__((ext_vector_type(4)));
__device__ __forceinline__ void kload8(bf16x8*kf,lds_cptr kp){
  kf[0]=*(const __attribute__((address_space(3))) bf16x8*)(kp);      kf[1]=*(const __attribute__((address_space(3))) bf16x8*)(kp+512);
  kf[2]=*(const __attribute__((address_space(3))) bf16x8*)(kp+2048); kf[3]=*(const __attribute__((address_space(3))) bf16x8*)(kp+2560);
  kf[4]=*(const __attribute__((address_space(3))) bf16x8*)(kp+4096); kf[5]=*(const __attribute__((address_space(3))) bf16x8*)(kp+4608);
  kf[6]=*(const __attribute__((address_space(3))) bf16x8*)(kp+6144); kf[7]=*(const __attribute__((address_space(3))) bf16x8*)(kp+6656);
}
__device__ __forceinline__ void kload2(bf16x8*kf,lds_cptr kp,int j){ kf[2*j]=*(const __attribute__((address_space(3))) bf16x8*)(kp+j*2048); kf[2*j+1]=*(const __attribute__((address_space(3))) bf16x8*)(kp+j*2048+512); }
__device__ __forceinline__ s16x4 vtr(lds_cptr p){ return __builtin_bit_cast(s16x4,__builtin_amdgcn_ds_read_tr16_b64_v4i16((__attribute__((address_space(3))) v4i16_t*)p)); }
__device__ __forceinline__ float rowmax(const f32x16&p0,const f32x16&p1){
  float a=max3f(p0[0],p0[1],p1[0]),b=max3f(p0[2],p0[3],p1[1]);a=max3f(a,p1[2],p1[3]);
  #pragma unroll
  for(int r=4;r<16;r+=4){a=max3f(a,p0[r],p0[r+1]);b=max3f(b,p0[r+2],p0[r+3]);a=max3f(a,p1[r],p1[r+1]);b=max3f(b,p1[r+2],p1[r+3]);}
  const float m=max2f(a,b);
  auto rr=__builtin_amdgcn_permlane32_swap(__float_as_uint(m),__float_as_uint(m),false,false);
  return max2f(__uint_as_float(rr[0]),__uint_as_float(rr[1]));
}
__device__ __forceinline__ void pv(f32x16*o,int vb,bf16x8 pa0,bf16x8 pa1,bf16x8 pa2,bf16x8 pa3){
  #pragma unroll
  for(int d0=0;d0<2;++d0){s16x4 lo[4],hi[4];
    #pragma unroll
    for(int ks=0;ks<4;++ks){
      asm volatile("ds_read_b64_tr_b16 %0,%1 offset:%c2":"=&v"(lo[ks]):"v"(vb),"i"(d0*4096+ks*1024):"memory");
      asm volatile("ds_read_b64_tr_b16 %0,%1 offset:%c2":"=&v"(hi[ks]):"v"(vb),"i"(d0*4096+ks*1024+512):"memory");}
    asm volatile("s_waitcnt lgkmcnt(0)":::"memory");SBAR();
    #define PK(k) (bf16x8){lo[k][0],lo[k][1],lo[k][2],lo[k][3],hi[k][0],hi[k][1],hi[k][2],hi[k][3]}
    o[d0]=__builtin_amdgcn_mfma_f32_32x32x16_bf16(pa0,PK(0),o[d0],0,0,0);
    o[d0]=__builtin_amdgcn_mfma_f32_32x32x16_bf16(pa1,PK(1),o[d0],0,0,0);
    o[d0]=__builtin_amdgcn_mfma_f32_32x32x16_bf16(pa2,PK(2),o[d0],0,0,0);
    o[d0]=__builtin_amdgcn_mfma_f32_32x32x16_bf16(pa3,PK(3),o[d0],0,0,0);
    #undef PK
  }
}

#ifndef ATTN_STORE16
#define ATTN_STORE16(p,v) (*(u32x4*)(p)=(v))
#endif
template<int THRL> __device__ __forceinline__ void attn_unit(const bf16*Q0,const bf16*__restrict__ Kh,const bf16*__restrict__ Vh,bf16*O0,const int NT,char*shm){
  const int tid=opaque_tid(),lane=tid&63,r32=lane&31,hi=lane>>5; const int wid=__builtin_amdgcn_readfirstlane(tid>>6);
  const bf16*Qw=Q0+(long)(wid*QBLK)*DM;
  const unsigned lds0=(unsigned)(uintptr_t)shm;
  float*wsf=(float*)(shm+LDS_WS)+wid*64;
  const bf16*ksrc=Kh+(long)lane*DM+wid*8;
  const bf16*vsrc=Vh+(long)(16*(wid&3)+(lane>>2))*DM+(wid>>2)*32+(lane&3)*8;
  const unsigned kdst=lds0+LDS_K+wid*1024, vdst=lds0+LDS_V+wid*1024;
  #define DMA_K(t,slot) glds16(ksrc+(long)(t)*KVBLK*DM,(unsigned)__builtin_amdgcn_readfirstlane(kdst+(slot)))
  #define DMA_V(t,slot) glds16(vsrc+(long)(t)*KVBLK*DM,(unsigned)__builtin_amdgcn_readfirstlane(vdst+(slot)))
  const int vb0=(int)(lds0+LDS_V)+((lane>>4)&1)*32+(lane&3)*8+(4*hi+((lane&15)>>2))*64;
  const char*Kbase=shm+LDS_K; bf16x8 kf[8];
  const lds_cptr shm3=(lds_cptr)shm; const lds_cptr kp0=shm3+LDS_K+hi*1024+r32*16; const lds_cptr vp0=shm3+LDS_V+((lane>>4)&1)*32+(lane&3)*8+(4*hi+((lane&15)>>2))*64;
  DMA_K(0,0);DMA_V(0,0);DMA_K(1,SLOTB);
  bf16x8 qr[4];
  #pragma unroll
  for(int d0=0;d0<4;++d0)qr[d0]=*reinterpret_cast<const bf16x8*>(&Qw[(long)r32*DM+d0*16+hi*8]);
  float mhat=0.f,l_reg=0.f;f32x16 o[2];o[0]=f32x16{};o[1]=f32x16{};f32x16 negm=f32x16{};asm volatile("":"+v"(negm));
  #define CMASK(P0,P1,t) do{}while(0)
  bool resc=false;
  #define START(P0,P1) do{ const float rm=rowmax(P0,P1); resc=false; \
    { const float dl=rm; mhat=fadd_s(mhat,dl); \
      _Pragma("unroll") for(int r=0;r<16;++r){P0[r]=fsub_s(P0[r],dl);P1[r]=fsub_s(P1[r],dl);} \
      _Pragma("unroll") for(int r=0;r<16;++r)negm[r]=-mhat; asm volatile("":"+v"(negm)); } \
    _Pragma("unroll") for(int r=0;r<16;++r)P0[r]=__builtin_amdgcn_exp2f(P0[r]); }while(0)
  #define RESC() do{ if(resc){ asm volatile("s_waitcnt lgkmcnt(0)":::"memory"); \
      _Pragma("unroll") for(int d_=0;d_<2;++d_) _Pragma("unroll") for(int r=0;r<16;++r)o[d_][r]*=wsf[crow(r,hi)]; } }while(0)
  f32x16 pA0,pA1,pB0,pB1;
  int sl_prev=0,sl_cur=0,sl_next=SLOTB;
  #define ROT() do{sl_prev=sl_cur;sl_cur=sl_next;sl_next=(sl_next==(NSLOT-1)*SLOTB)?0:sl_next+SLOTB;}while(0)
  DMA_K(2,2*SLOTB);
  WAIT_BAR(3);
  qkt(pA0,pA1,Kbase,qr,negm,r32,hi);asm volatile("s_nop 15\n\ts_nop 7":"+v"(pA0),"+v"(pA1));CMASK(pA0,pA1,0);
  START(pA0,pA1);
  _Pragma("unroll") for(int r=0;r<16;++r)pA1[r]=__builtin_amdgcn_exp2f(pA1[r]);
  WAIT_BAR(0);
  DMA_K(3,0);DMA_V(1,SLOTB);
  ROT();
  kload8(kf,kp0+sl_cur);
  WAIT_BAR(2);
  s16x4 vlo[8],vhi[8]; u32x4 pw0,pw1,pw2,pw3;
  #define PKW(P,B) cvtpk_s(P[B],P[B+1])
  #define PAF(k) __builtin_bit_cast(bf16x8,pw##k)
  #define VFR(i) (bf16x8){vlo[i][0],vlo[i][1],vlo[i][2],vlo[i][3],vhi[i][0],vhi[i][1],vhi[i][2],vhi[i][3]}
  #define PIN(x) asm volatile("":"+v"(x))
  #define MX3(a,b,c) __builtin_fmaxf(__builtin_fmaxf((a),(b)),(c))
  #define GAPA(MF,A0,A1,A2,A3,W0,W1,PW) do{ MF; sacc+=A0; sacc+=A1; sacc+=A2; sacc+=A3; PIN(sacc); W0; W1; PIN(PW); SBAR(); }while(0)
  #define EX(v) __builtin_amdgcn_exp2f(v)
  #define GAPB(MF,X,B) do{ MF; X[B]=EX(X[B]); X[B+1]=EX(X[B+1]); X[B+2]=EX(X[B+2]); X[B+3]=EX(X[B+3]); PIN(X); SBAR(); }while(0)
  #define VRD(i) do{ vlo[i]=vtr(vp_+(((i)>>2)*4096+((i)&3)*1024)); vhi[i]=vtr(vp_+(((i)>>2)*4096+((i)&3)*1024+512)); }while(0)
  #define KRD(G,j) do{ if(G){ kload2(kf,kp0+sl_next,j); SBAR(); } }while(0)
  #define STEP(C0,C1,P0,P1,t,GK,GV,GL) do{ SBAR(); \
    const lds_cptr vp_=vp0+sl_prev; \
    VRD(0); SBAR(); float sacc=(P0[0]+P0[1]); \
    GAPA(C0=__builtin_amdgcn_mfma_f32_32x32x16_bf16(kf[0],qr[0],negm,0,0,0), P0[2],P0[3],P0[4],P0[5],     pw0[0]=PKW(P0,0), pw0[1]=PKW(P0,2), pw0); \
    VRD(4); SBAR(); GAPA(C1=__builtin_amdgcn_mfma_f32_32x32x16_bf16(kf[1],qr[0],negm,0,0,0), P0[6],P0[7],P0[8],P0[9],     pw0[2]=PKW(P0,4), pw0[3]=PKW(P0,6), pw0); \
    VRD(1); SBAR(); GAPA(C0=__builtin_amdgcn_mfma_f32_32x32x16_bf16(kf[2],qr[1],C0,0,0,0),   P0[10],P0[11],P0[12],P0[13], pw1[0]=PKW(P0,8), pw1[1]=PKW(P0,10), pw1); \
    VRD(5); SBAR(); GAPA(C1=__builtin_amdgcn_mfma_f32_32x32x16_bf16(kf[3],qr[1],C1,0,0,0),   P0[14],P0[15],P1[0],P1[1],   pw1[2]=PKW(P0,12),pw1[3]=PKW(P0,14), pw1); \
    VRD(2); SBAR(); GAPA(C0=__builtin_amdgcn_mfma_f32_32x32x16_bf16(kf[4],qr[2],C0,0,0,0),   P1[2],P1[3],P1[4],P1[5],     pw2[0]=PKW(P1,0), pw2[1]=PKW(P1,2), pw2); \
    VRD(6); SBAR(); GAPA(C1=__builtin_amdgcn_mfma_f32_32x32x16_bf16(kf[5],qr[2],C1,0,0,0),   P1[6],P1[7],P1[8],P1[9],     pw2[2]=PKW(P1,4), pw2[3]=PKW(P1,6), pw2); \
    VRD(3); SBAR(); GAPA(C0=__builtin_amdgcn_mfma_f32_32x32x16_bf16(kf[6],qr[3],C0,0,0,0),   P1[10],P1[11],P1[12],P1[13], pw3[0]=PKW(P1,8), pw3[1]=PKW(P1,10), pw3); \
    VRD(7); SBAR(); GAPA(C1=__builtin_amdgcn_mfma_f32_32x32x16_bf16(kf[7],qr[3],C1,0,0,0),   P1[14],P1[15],0.f,0.f,       pw3[2]=PKW(P1,12),pw3[3]=PKW(P1,14), pw3); \
    l_reg+=sacc; \
    if(GK){DMA_K((t)+3,sl_cur);} if(GV){DMA_V((t)+1,sl_next);} \
    CMASK(C0,C1,t); \
    { float a=MX3(C0[0],C0[1],C1[0]),b=MX3(C0[2],C0[3],C1[1]); a=MX3(a,C1[2],C1[3]); \
      _Pragma("unroll") for(int r=4;r<16;r+=4){a=MX3(a,C0[r],C0[r+1]);b=MX3(b,C0[r+2],C0[r+3]);a=MX3(a,C1[r],C1[r+1]);b=MX3(b,C1[r+2],C1[r+3]);} \
      float rm=__builtin_fmaxf(a,b); { auto rr=__builtin_amdgcn_permlane32_swap(__float_as_uint(rm),__float_as_uint(rm),false,false); rm=__builtin_fmaxf(__uint_as_float(rr[0]),__uint_as_float(rr[1])); } \
      resc=false; \
      if(__builtin_expect(__any(rm>(float)THRL),0)){ const float dl=__builtin_fmaxf(rm,0.f); mhat+=dl; \
        _Pragma("unroll") for(int r=0;r<16;++r){C0[r]-=dl;C1[r]-=dl;} \
        _Pragma("unroll") for(int r=0;r<16;++r)negm[r]=-mhat; asm volatile("":"+v"(negm)); \
        const float f=__builtin_amdgcn_exp2f(-dl); l_reg*=f; if(hi==0)wsf[r32]=f; resc=true; } } \
    SBAR(); \
    GAPB(o[0]=__builtin_amdgcn_mfma_f32_32x32x16_bf16(PAF(0),VFR(0),o[0],0,0,0), C0,0); \
    GAPB(o[1]=__builtin_amdgcn_mfma_f32_32x32x16_bf16(PAF(0),VFR(4),o[1],0,0,0), C0,4); \
    KRD(GL,0); GAPB(o[0]=__builtin_amdgcn_mfma_f32_32x32x16_bf16(PAF(1),VFR(1),o[0],0,0,0), C0,8); \
    KRD(GL,1); GAPB(o[1]=__builtin_amdgcn_mfma_f32_32x32x16_bf16(PAF(1),VFR(5),o[1],0,0,0), C0,12); \
    KRD(GL,2); GAPB(o[0]=__builtin_amdgcn_mfma_f32_32x32x16_bf16(PAF(2),VFR(2),o[0],0,0,0), C1,0); \
    KRD(GL,3); GAPB(o[1]=__builtin_amdgcn_mfma_f32_32x32x16_bf16(PAF(2),VFR(6),o[1],0,0,0), C1,4); \
    GAPB(o[0]=__builtin_amdgcn_mfma_f32_32x32x16_bf16(PAF(3),VFR(3),o[0],0,0,0), C1,8); \
    GAPB(o[1]=__builtin_amdgcn_mfma_f32_32x32x16_bf16(PAF(3),VFR(7),o[1],0,0,0), C1,12); \
    }while(0)
  int t=1;
  #undef CMASK
  #define CMASK(P0,P1,t) do{}while(0)
  for(;t+5<NT;t+=2){
    STEP(pB0,pB1,pA0,pA1,t,true,true,true);     WAIT_BAR(2); RESC(); ROT();
    STEP(pA0,pA1,pB0,pB1,t+1,true,true,true);   WAIT_BAR(2); RESC(); ROT();
  }
  #undef CMASK
  #define CMASK(P0,P1,t) do{}while(0)
  #define ENDW(tt) do{ if((tt)+3<NT){WAIT_BAR(2);} else if((tt)+2<NT){WAIT_BAR(1);} else {WAIT_BAR(0);} }while(0)
  for(;t+1<NT;t+=2){
    STEP(pB0,pB1,pA0,pA1,t,(t+3<NT),(t+1<NT),(t+1<NT));       ENDW(t);   RESC(); ROT();
    STEP(pA0,pA1,pB0,pB1,t+1,(t+4<NT),(t+2<NT),(t+2<NT));     ENDW(t+1); RESC(); ROT();
  }
  STEP(pB0,pB1,pA0,pA1,NT-1,false,false,false); RESC();
  { float sacc=pB0[0]+pB0[1]; _Pragma("unroll") for(int r=2;r<16;++r)sacc+=pB0[r]; _Pragma("unroll") for(int r=0;r<16;++r)sacc+=pB1[r]; l_reg+=sacc;
    pw0=(u32x4){PKW(pB0,0),PKW(pB0,2),PKW(pB0,4),PKW(pB0,6)};pw1=(u32x4){PKW(pB0,8),PKW(pB0,10),PKW(pB0,12),PKW(pB0,14)};pw2=(u32x4){PKW(pB1,0),PKW(pB1,2),PKW(pB1,4),PKW(pB1,6)};pw3=(u32x4){PKW(pB1,8),PKW(pB1,10),PKW(pB1,12),PKW(pB1,14)};
    SBAR(); pv(o,vb0+sl_cur,PAF(0),PAF(1),PAF(2),PAF(3)); }
  #undef PKW
  #undef PAF
  #undef VFR
  #undef PIN
  #undef MX3
  #undef GAPA
  #undef GAPB
  #undef EX
  #undef VRD
  #undef KRD
  #undef STEP
  #undef ENDW
  {auto rr=__builtin_amdgcn_permlane32_swap(__float_as_uint(l_reg),__float_as_uint(l_reg),false,false);l_reg=__uint_as_float(rr[0])+__uint_as_float(rr[1]);}
  if(hi==0)wsf[32+r32]=l_reg;asm volatile("s_waitcnt lgkmcnt(0)":::"memory");
  float rli[16];
  #pragma unroll
  for(int r=0;r<16;++r)rli[r]=__builtin_amdgcn_rcpf(wsf[32+crow(r,hi)]);
  bf16*Ow=O0+(long)(wid*QBLK)*DMO;
  { bf16*stg=(bf16*)(shm+LDS_OST)+wid*2048;
    #pragma unroll
    for(int r=0;r<16;++r){const int orow=crow(r,hi);
      #pragma unroll
      for(int d0=0;d0<2;++d0)stg[orow*64+d0*32+r32]=__float2bfloat16(o[d0][r]*rli[r]);}
    asm volatile("s_waitcnt lgkmcnt(0)":::"memory");
    #pragma unroll
    for(int i=0;i<4;++i){const int row=i*8+(lane>>3),ch=lane&7; const u32x4 v=*(const u32x4*)(stg+row*64+ch*8); ATTN_STORE16(Ow+(long)row*DMO+ch*8,v);} }
  asm volatile("s_waitcnt lgkmcnt(0)\n\ts_barrier":::"memory");
  #undef DMA_K
  #undef DMA_V
  #undef CMASK
  #undef START
  #undef RESC
  #undef ROT
}
constexpr int ATTN_LDS_BYTES=LDS_BYTES;
#undef SBAR
#undef WAIT_BAR
}
#define LAS __attribute__((address_space(3)))
typedef unsigned short bf16;
typedef float f32x4 __attribute__((ext_vector_type(4)));
typedef float cpx __attribute__((ext_vector_type(2)));
typedef unsigned u32x2 __attribute__((ext_vector_type(2)));
typedef unsigned u32x4v __attribute__((ext_vector_type(4)));
__device__ __forceinline__ cpx mk2(float a, float b) { cpx r; r.x = a; r.y = b; return r; }
constexpr int NWAVES = 8, NTHR = 512;
constexpr int DM_ = 1024, BATCH = 8, SEQ = 2048, CTXL = 256, DEPTH = 4, DFF = 2816, INW = 1792, RPB = SEQ + CTXL  , MROWS = BATCH * RPB  ;
constexpr float EPS = 1e-6f;
constexpr size_t MiB = 1u << 20;
constexpr size_t WS_MOD = 0, WS_BAR = 1536 * 1024, WS_BAR_BYTES = 16384;
constexpr size_t WS_WGU = 2 * MiB, WS_WD = 90 * MiB, WS_WIN = 134 * MiB, WS_WOUT = 148 * MiB;
constexpr size_t WS_H = 156 * MiB, WS_Y = 228 * MiB, WS_ACT = 264 * MiB, WS_P = 363 * MiB, WS_MIX = 426 * MiB;
constexpr size_t WS_KT = WS_ACT, WS_KTC = WS_ACT + 32 * MiB;
constexpr size_t WS_KF = 462 * MiB, WS_KFC = 526 * MiB, WS_FPART = 534 * MiB, WS_SS = 537 * MiB, WS_SB = 539 * MiB, WS_END = 541 * MiB;
constexpr int SB_IN = 9 * 5632, SB_G2 = SB_IN + 9 * 1792, SB_PER_L = SB_G2 + 9 * 5632;
constexpr int LDS_BYTES = 147456;

struct Args {
    const float *x, *c, *ctx, *c_ctx, *norm_g, *w_mod, *b_mod, *w_gate, *w_up, *w_down, *w_in, *w_out, *pool_w, *pool_scale, *conv_w, *conv_b,
                *f_w1, *f_b1, *f_w2, *f_b2, *f_w3, *sin_freq, *hy_bias, *q_g, *k_g;
    float* out; unsigned char* ws;
};

__device__ __forceinline__ unsigned f2bf(float f) { unsigned u = __builtin_bit_cast(unsigned, f); return (u + 0x7fffu + ((u >> 16) & 1u)) >> 16; }
__device__ __forceinline__ unsigned pk2(float lo, float hi) { return f2bf(lo) | (f2bf(hi) << 16); }
__device__ __forceinline__ float bf2f(bf16 v) { return __builtin_bit_cast(float, (unsigned)v << 16); }
__device__ __forceinline__ float wave_sum(float v) {
#pragma unroll
    for (int o = 1; o < 64; o <<= 1) v += __shfl_xor(v, o);
    return v;
}

__device__ __forceinline__ void transpose_item(const float* W, int K, int N, bf16* WT, int mode, LAS float* scr, int item, int lane) {
    const int nblk = N / 32, kb = item / nblk, nb = item % nblk, k0 = 64 * kb, n0 = 32 * nb;
#pragma unroll 8
    for (int i = 0; i < 32; ++i) { const int kk = 2 * i + (lane >> 5); scr[kk * 33 + (lane & 31)] = W[(size_t)(k0 + kk) * N + n0 + (lane & 31)]; }
    asm volatile("s_waitcnt lgkmcnt(0)" ::: "memory");
    const int c = lane & 7;
#pragma unroll
    for (int j = 0; j < 4; ++j) { const int n = (lane >> 3) + 8 * j; const LAS float* s = scr + (8 * c) * 33 + n;
        u32x4v o; o.x = pk2(s[0 * 33], s[1 * 33]); o.y = pk2(s[2 * 33], s[3 * 33]); o.z = pk2(s[4 * 33], s[5 * 33]); o.w = pk2(s[6 * 33], s[7 * 33]);
        const int f = n0 + n; const int drow = (mode == 0) ? f : (256 * (f >> 7) + (f & 127) + (mode == 2 ? 128 : 0));
        *(u32x4v*)(WT + (size_t)drow * K + k0 + 8 * c) = o; }
    asm volatile("s_waitcnt lgkmcnt(0)" ::: "memory");
}

__device__ __forceinline__ void mod_item(const Args& A, int item, LAS unsigned char* lds) {
    const int tid = opaque_tid(); const int lane = tid & 63, wid = tid >> 6; const int l = item / 36, cb = item % 36;
    LAS float* a = (LAS float*)lds;
    LAS float* red = a + 9 * 1024;
    for (int i = tid; i < 9 * 1024; i += NTHR) { const int j = i >> 10, k = i & 1023; const float v = (j < 8) ? A.c[j * 1024 + k] : A.c_ctx[k]; a[i] = v / (1.0f + __expf(-v)); }
    __syncthreads();
    { f32x4 acc[9];
#pragma unroll
      for (int j = 0; j < 9; ++j) acc[j] = (f32x4){0.f, 0.f, 0.f, 0.f};
      const int k0 = wid * 128; const float* wp = A.w_mod + ((size_t)l * 1024 + k0) * 9216 + cb * 256 + lane * 4;
#pragma unroll 8
      for (int kk = 0; kk < 128; ++kk) { const f32x4 w = *(const f32x4*)(wp + (size_t)kk * 9216);
#pragma unroll
          for (int j = 0; j < 9; ++j) acc[j] += w * a[j * 1024 + k0 + kk]; }
#pragma unroll
      for (int j = 0; j < 9; ++j) *(LAS f32x4*)(red + (wid * 9 + j) * 256 + lane * 4) = acc[j]; }
    __syncthreads();
    float* mo = (float*)(A.ws + WS_MOD) + (size_t)l * 9 * 9216 + cb * 256;
    for (int i = tid; i < 9 * 256; i += NTHR) { const int j = i >> 8, col = i & 255; float s = A.b_mod[(size_t)l * 9216 + cb * 256 + col];
#pragma unroll
        for (int w = 0; w < 8; ++w) s += red[(w * 9 + j) * 256 + col];
        mo[(size_t)j * 9216 + col] = s; }
    __syncthreads();
}

__device__ __forceinline__ void filter_item(const Args& A, int item, LAS unsigned char* lds) {
    const int tid = opaque_tid(); const int l = item / 144, r = item % 144; const int Lsel = (r >= 128) ? 1 : 0; const int L = Lsel ? 256 : 2048; const int t0 = (Lsel ? (r - 128) : r) * 16;
    LAS float* z = (LAS float*)lds;
    LAS float* h1 = z + 16 * 33;
    LAS float* h2 = h1 + 16 * 64;
    for (int i = tid; i < 16 * 33; i += NTHR) { const int tt = i / 33, e = i % 33; const int t = t0 + tt; float v;
        if (e == 0) v = (float)t / (float)(L - 1);
        else { const int j = (e - 1) & 15; const float freq = 1e-4f + (float)j * ((15.0f - 1e-4f) / 15.0f); const float ang = (6.283185307179586f * (float)t / (float)L) * freq; v = (e <= 16) ? __cosf(ang) : -__sinf(ang); }
        z[i] = v; }
    __syncthreads();
    const float* w1 = A.f_w1 + (size_t)l * 33 * 64; const float* w2 = A.f_w2 + (size_t)l * 64 * 64; const float* w3 = A.f_w3 + (size_t)l * 64 * 1024;
    for (int i = tid; i < 16 * 64; i += NTHR) { const int tt = i >> 6, j = i & 63; float s = A.f_b1[l * 64 + j];
        for (int e = 0; e < 33; ++e) s += z[tt * 33 + e] * w1[e * 64 + j];
        h1[i] = __sinf(A.sin_freq[(l * 2 + 0) * 64 + j] * s); }
    __syncthreads();
    for (int i = tid; i < 16 * 64; i += NTHR) { const int tt = i >> 6, j = i & 63; float s = A.f_b2[l * 64 + j];
        for (int e = 0; e < 64; ++e) s += h1[tt * 64 + e] * w2[e * 64 + j];
        h2[j * 16 + tt] = __sinf(A.sin_freq[(l * 2 + 1) * 64 + j] * s); }
    __syncthreads();
    float* KT = Lsel ? (float*)(A.ws + WS_KTC) + (size_t)l * 512 * 512 : (float*)(A.ws + WS_KT) + (size_t)l * 512 * 4096;
    float* FP = (float*)(A.ws + WS_FPART) + ((size_t)l * 144 + r) * 1024;
    const float min_decay = -3.0701134573253945f, max_decay = -15.350567286626973f;
#pragma unroll 1
    for (int half = 0; half < 2; ++half) { const int n = tid + half * NTHR; const int o = n >> 9, dir = (n >> 8) & 1, c = n & 255;
        float acc[16];
#pragma unroll
        for (int tt = 0; tt < 16; ++tt) acc[tt] = 0.f;
#pragma unroll 8
        for (int j = 0; j < 64; ++j) { const float w = w3[j * 1024 + n];
#pragma unroll
            for (int q = 0; q < 4; ++q) { const f32x4 hv = *(const LAS f32x4*)(h2 + j * 16 + 4 * q); acc[4 * q] += hv.x * w; acc[4 * q + 1] += hv.y * w; acc[4 * q + 2] += hv.z * w; acc[4 * q + 3] += hv.w * w; } }
        const float delta = fabsf(min_decay + (float)c * ((max_decay - min_decay) / 255.0f));
        float* kp = KT + (size_t)(o * 256 + c) * (2 * L); float asum = 0.f;
#pragma unroll
        for (int tt = 0; tt < 16; ++tt) { const int t = t0 + tt; const float v = acc[tt] * __expf(-((float)t / (float)(L - 1)) * delta);
            if (dir == 0) { kp[t] = v; asum += fabsf(v); } else if (t > 0) { kp[2 * L - t] = v; asum += fabsf(v); } }
        if (dir == 0 && t0 == 0) kp[L] = 0.f;
        FP[n] = asum; }
    __syncthreads();
}

__device__ __forceinline__ cpx cmul(cpx a, cpx b) { return mk2(a.x * b.x - a.y * b.y, a.x * b.y + a.y * b.x); }
__device__ __forceinline__ cpx cmulc(cpx a, cpx b) { return mk2(a.x * b.x + a.y * b.y, a.y * b.x - a.x * b.y); }
__device__ __forceinline__ cpx cadd(cpx a, cpx b) { return mk2(a.x + b.x, a.y + b.y); }
__device__ __forceinline__ cpx csub(cpx a, cpx b) { return mk2(a.x - b.x, a.y - b.y); }
__device__ __forceinline__ cpx cis_rev(float r) { return mk2(__builtin_amdgcn_cosf(r), __builtin_amdgcn_sinf(r)); }
#define PADI(i) ((i) + ((i) >> 4))
__device__ __forceinline__ cpx csq(cpx a) { return mk2(a.x * a.x - a.y * a.y, 2.f * a.x * a.y); }
struct Tw { cpx w, wr; };
__device__ __forceinline__ Tw mktw(cpx w, bool conj) { Tw t; if (conj) { t.w = mk2(w.x, -w.y); t.wr = mk2(w.y, w.x); } else { t.w = w; t.wr = mk2(-w.y, w.x); } return t; }
__device__ __forceinline__ cpx cmt(cpx a, const Tw& t) { return a.xx * t.w + a.yy * t.wr; }
__device__ __forceinline__ void bf4_fwd(cpx& a0, cpx& a1, cpx& a2, cpx& a3, const Tw& w1, const Tw& w2) {
    const cpx b0 = a0 + a2, b2 = cmt(a0 - a2, w1), b1 = a1 + a3, t = cmt(a1 - a3, w1), b3 = mk2(t.y, -t.x);
    a0 = b0 + b1; a1 = cmt(b0 - b1, w2); a2 = b2 + b3; a3 = cmt(b2 - b3, w2);
}
__device__ __forceinline__ void bf4_inv(cpx& c0, cpx& c1, cpx& c2, cpx& c3, const Tw& w1c, const Tw& w2c) {
    const cpx t1 = cmt(c1, w2c), b0 = c0 + t1, b1 = c0 - t1, t3 = cmt(c3, w2c), b2 = c2 + t3, b3 = c2 - t3;
    const cpx u2 = cmt(b2, w1c), t = cmt(b3, w1c), u3 = mk2(-t.y, t.x);
    c0 = b0 + u2; c1 = b1 + u3; c2 = b0 - u2; c3 = b1 - u3;
}
template <bool INV, int lQ> __device__ __forceinline__ void fft_dp(LAS cpx* x, int j) {
    asm volatile("" : "+v"(j));
    constexpr int Q = 1 << lQ, q4 = Q >> 2; const int blk = j >> (lQ - 2), pos0 = j & (q4 - 1), base = (blk << (lQ + 2)) + pos0;
    LAS cpx* xb = x + PADI(base);
    cpx e[4][4];
#pragma unroll
    for (int a = 0; a < 4; ++a)
#pragma unroll
        for (int b = 0; b < 4; ++b) e[a][b] = xb[PADI(a * Q + b * q4)];
    const cpx w10 = cis_rev(-(float)pos0 / (float)(4 * Q)); const cpx w1p = csq(csq(w10)); const Tw t1p = mktw(w1p, INV), t2p = mktw(csq(w1p), INV);
    const cpx C1 = mk2(0.92387953251128674f, -0.38268343236508977f), C2 = mk2(0.70710678118654752f, -0.70710678118654752f), C3 = mk2(0.38268343236508977f, -0.92387953251128674f);
    if (INV) {
#pragma unroll
        for (int a = 0; a < 4; ++a) bf4_inv(e[a][0], e[a][1], e[a][2], e[a][3], t1p, t2p); }
#pragma unroll
    for (int b = 0; b < 4; ++b) { const cpx w1 = (b == 0) ? w10 : cmul(w10, b == 1 ? C1 : (b == 2 ? C2 : C3)); const Tw t1 = mktw(w1, INV), t2 = mktw(csq(w1), INV);
        if (INV) bf4_inv(e[0][b], e[1][b], e[2][b], e[3][b], t1, t2); else bf4_fwd(e[0][b], e[1][b], e[2][b], e[3][b], t1, t2); }
    if (!INV) {
#pragma unroll
        for (int a = 0; a < 4; ++a) bf4_fwd(e[a][0], e[a][1], e[a][2], e[a][3], t1p, t2p); }
#pragma unroll
    for (int a = 0; a < 4; ++a)
#pragma unroll
        for (int b = 0; b < 4; ++b) xb[PADI(a * Q + b * q4)] = e[a][b];
}
template <int N> __device__ __forceinline__ void fft_fwd(LAS cpx* x, int j) {
    if (N == 512) { for (int i = j; i < 256; i += 32) { const cpx a = x[PADI(i)], b = x[PADI(i + 256)]; const cpx w = cis_rev(-(float)i / 512.f); x[PADI(i)] = cadd(a, b); x[PADI(i + 256)] = cmul(csub(a, b), w); } __syncthreads(); }
    if (N != 512) { fft_dp<false, 10>(x, j); __syncthreads(); }
    fft_dp<false, 6>(x, j); __syncthreads();
    fft_dp<false, 2>(x, j); __syncthreads();
}
template <int N> __device__ __forceinline__ void fft_inv(LAS cpx* x, int j) {
    fft_dp<true, 2>(x, j); __syncthreads();
    fft_dp<true, 6>(x, j); __syncthreads();
    if (N != 512) { fft_dp<true, 10>(x, j); __syncthreads(); }
    if (N == 512) { for (int i = j; i < 256; i += 32) { const cpx w = cis_rev(-(float)i / 512.f); const cpx a = x[PADI(i)], b = cmulc(x[PADI(i + 256)], w); x[PADI(i)] = cadd(a, b); x[PADI(i + 256)] = csub(a, b); } __syncthreads(); }
}

template <int L, int CH> __device__ __forceinline__ void filter_fft_item(const Args& A, int item, LAS unsigned char* lds) {
    constexpr int N = 2 * L, TPF = NTHR / CH, NB = N + N / 16, NCH = L / 16; static_assert(TPF * 16 == N && 2 * NCH <= TPF, "geometry");
    const int tid = opaque_tid(); const int fi = tid / TPF, j = tid % TPF; const int l = item / (512 / CH), oc = (item % (512 / CH)) * CH + fi;
    LAS cpx* buf = (LAS cpx*)lds + fi * NB;
    LAS float* redn = (LAS float*)(lds + CH * NB * 8) + fi * TPF;
    { const int o = oc >> 8, c = oc & 255; float v = 0.f;
      if (j < 2 * NCH) { const int chunk = j >> 1, dir = j & 1; v = ((const float*)(A.ws + WS_FPART))[((size_t)l * 144 + (L == 2048 ? 0 : 128) + chunk) * 1024 + o * 512 + dir * 256 + c]; }
      redn[j] = v; __syncthreads();
      for (int st = TPF / 2; st > 0; st >>= 1) { if (j < st) redn[j] += redn[j + st]; __syncthreads(); } }
    const float nrm = redn[0];
    const float* kt = (L == 2048 ? (const float*)(A.ws + WS_KT) : (const float*)(A.ws + WS_KTC)) + ((size_t)l * 512 + oc) * N;
    const float s = 1.0f / (nrm * (float)N);
#pragma unroll
    for (int k = 0; k < 16; ++k) { const int i = j + k * TPF; buf[PADI(i)] = mk2(kt[i] * s, 0.f); }
    __syncthreads();
    fft_fwd<N>(buf, j);
    cpx* kf = (L == 2048 ? (cpx*)(A.ws + WS_KF) : (cpx*)(A.ws + WS_KFC)) + ((size_t)l * 512 + oc) * N;
#pragma unroll
    for (int k = 0; k < 16; ++k) { const int i = j + k * TPF; kf[i] = buf[PADI(i)]; }
    __syncthreads();
}

__device__ __forceinline__ void prologue_rows(const Args& A, int G) {
    const int tid = opaque_tid(); const int lane = tid & 63, wid = tid >> 6; const int gw = blockIdx.x * NWAVES + wid, NGW = G * NWAVES;
    bf16* H = (bf16*)(A.ws + WS_H); bf16* HS = (bf16*)(A.ws + WS_Y); float* SS = (float*)(A.ws + WS_SS);
    const float* g = A.norm_g; const float* mod = (const float*)(A.ws + WS_MOD);
    for (int row = gw; row < MROWS; row += NGW) { const int b = row / RPB, j = row % RPB; const int mb = (j >= SEQ) ? 8 : b;
        const float* src = (j < SEQ) ? A.x + ((size_t)b * SEQ + j) * 1024 : A.ctx + ((size_t)b * CTXL + (j - SEQ)) * 1024;
        const float* scale = mod + ((size_t)mb * 9 + 1) * 1024;
        f32x4 v[4]; float ss = 0.f;
#pragma unroll
        for (int q = 0; q < 4; ++q) { v[q] = *(const f32x4*)(src + 256 * q + 4 * lane); ss += (v[q].x * v[q].x + v[q].y * v[q].y) + (v[q].z * v[q].z + v[q].w * v[q].w); }
#pragma unroll
        for (int q = 0; q < 4; ++q) { const int d = 256 * q + 4 * lane; { u32x2 hw; hw.x = pk2(v[q].x, v[q].y); hw.y = pk2(v[q].z, v[q].w); *(u32x2*)(H + (size_t)row * 1024 + d) = hw; }
            const f32x4 y = v[q] * (*(const f32x4*)(g + d) * (1.0f + *(const f32x4*)(scale + d)));
            u32x2 w; w.x = pk2(y.x, y.y); w.y = pk2(y.z, y.w); *(u32x2*)(HS + (size_t)row * 1024 + d) = w; }
        ss = wave_sum(ss);
        if (lane < 16) SS[(size_t)row * 16 + lane] = (lane == 0) ? ss : 0.f;
    }
}
__device__ __forceinline__ void sb_items(const Args& A, int G, LAS unsigned char* lds) {
    const int tid = opaque_tid(); const int lane = tid & 63, wid = tid >> 6; const int gw = blockIdx.x * NWAVES + wid, NGW = G * NWAVES;
    LAS float* red = (LAS float*)(lds + wid * 16384);
    const float* mod = (const float*)(A.ws + WS_MOD); float* SB = (float*)(A.ws + WS_SB);
    constexpr int TOTAL = DEPTH * 13056; const int per = (TOTAL + NGW - 1) / NGW; const int it0 = gw * per, it1 = (it0 + per < TOTAL) ? it0 + per : TOTAL;
    auto wrow_of = [&](int it) -> const bf16* { const int l = it / 13056, r = it % 13056;
        if (r < 5632) return (const bf16*)(A.ws + WS_WGU) + ((size_t)(l * 2 + 0) * 5632 + r) * 1024;
        if (r < 7424) return (const bf16*)(A.ws + WS_WIN) + ((size_t)l * 1792 + (r - 5632)) * 1024;
        return (const bf16*)(A.ws + WS_WGU) + ((size_t)(l * 2 + 1) * 5632 + (r - 7424)) * 1024; };
    f32x4 shv[9][4]; int cur = -1; u32x4v w0 = (u32x4v){0u, 0u, 0u, 0u}, w1 = w0;
    if (it0 < it1) { const bf16* wr_ = wrow_of(it0); w0 = *(const u32x4v*)(wr_ + lane * 16); w1 = *(const u32x4v*)(wr_ + lane * 16 + 8); }
#pragma unroll 1
    for (int it = it0; it < it1; ++it) { const int l = it / 13056, r = it % 13056; const int reg = (r < 5632) ? 0 : (r < 7424 ? 1 : 2); const int combo = l * 3 + reg;
        const int n = (reg == 0) ? r : (reg == 1 ? r - 5632 : r - 7424), N = (reg == 1) ? 1792 : 5632; float* dst = SB + (size_t)l * SB_PER_L + (reg == 0 ? 0 : (reg == 1 ? SB_IN : SB_G2));
        if (combo != cur) { cur = combo;
#pragma unroll
            for (int mb = 0; mb < 9; ++mb) { const float* sh = mod + ((size_t)(l * 9 + mb) * 9 + 3 * reg) * 1024 + lane * 16;
#pragma unroll
                for (int q = 0; q < 4; ++q) shv[mb][q] = *(const f32x4*)(sh + 4 * q); } }
        float wf[16];
#pragma unroll
        for (int e = 0; e < 4; ++e) { wf[2 * e] = __builtin_bit_cast(float, w0[e] << 16); wf[2 * e + 1] = __builtin_bit_cast(float, w0[e] & 0xffff0000u); wf[8 + 2 * e] = __builtin_bit_cast(float, w1[e] << 16); wf[8 + 2 * e + 1] = __builtin_bit_cast(float, w1[e] & 0xffff0000u); }
        if (it + 1 < it1) { const bf16* wr_ = wrow_of(it + 1); w0 = *(const u32x4v*)(wr_ + lane * 16); w1 = *(const u32x4v*)(wr_ + lane * 16 + 8); }
#pragma unroll
        for (int mb = 0; mb < 9; ++mb) { float s_ = 0.f;
#pragma unroll
            for (int q = 0; q < 4; ++q) { const f32x4 a = shv[mb][q]; s_ += (a.x * wf[4 * q] + a.y * wf[4 * q + 1]) + (a.z * wf[4 * q + 2] + a.w * wf[4 * q + 3]); }
            red[mb * 64 + lane] = s_; }
        asm volatile("s_waitcnt lgkmcnt(0)" ::: "memory");
        if (lane < 9) { const LAS f32x4* rr = (const LAS f32x4*)(red + lane * 64); f32x4 t = rr[0];
#pragma unroll
            for (int q = 1; q < 16; ++q) t += rr[q];
            dst[(size_t)lane * N + n] = (t.x + t.y) + (t.z + t.w); }
        asm volatile("s_waitcnt lgkmcnt(0)" ::: "memory");
    }
}

__device__ __forceinline__ void prep_item(const Args& A, int l, int tt, LAS unsigned char* lds) {
    const int tid = opaque_tid(), lane = tid & 63, wid = tid >> 6;
    const int b = tt / 36, jt = tt % 36; const bool is_ctx = jt >= 32; const int seq_t0 = is_ctx ? (jt - 32) * 64 : jt * 64; const int Lseq = is_ctx ? CTXL : SEQ;
    const int seq_row0 = b * RPB + (is_ctx ? SEQ : 0), row0 = seq_row0 + seq_t0;
    bf16* P = (bf16*)(A.ws + WS_P); bf16* MIX = (bf16*)(A.ws + WS_MIX);
    LAS bf16* U = (LAS bf16*)lds;
    for (int i = tid; i < 80 * 32; i += NTHR) { const int r = i >> 5, ck = i & 31; const int t = seq_t0 - 8 + r; u32x4v v = (u32x4v){0u,0u,0u,0u};
        if (t >= 0 && t < Lseq) v = *(const u32x4v*)(P + (size_t)(seq_row0 + t) * INW + ck * 8);
        *(LAS u32x4v*)(U + r * 256 + ck * 8) = v; }
    { LAS cpx* CS = (LAS cpx*)(lds + 106496);
      LAS float* GV = (LAS float*)(lds + 106496 + 16384);
      if (!is_ctx) for (int i = tid; i < 64 * 32; i += NTHR) { const int tl = i >> 5, a = i & 31; const int t = seq_t0 + tl;
          const float inv_freq = exp2f(-13.287712379549449f * (float)(a & 15) * (1.0f / 16.0f));
          const float ang = ((a & 16) ? (float)(t & 63) : (float)(t >> 6)) * inv_freq; CS[i] = mk2(__cosf(ang), __sinf(ang)); }
      if (tid < 128) GV[tid] = (tid < 64) ? A.q_g[l * 64 + tid] * 0.18033688011112042f : A.k_g[l * 64 + tid - 64];
      __syncthreads();
#pragma unroll 1
      for (int p = tid; p < 640; p += NTHR) { const int tl = p / 10, hd = p - tl * 10; bf16* prow = P + (size_t)(row0 + tl) * INW + 1024 + hd * 64;
          u32x4v raw[8];
#pragma unroll
          for (int q = 0; q < 8; ++q) raw[q] = *(const u32x4v*)(prow + 8 * q);
          float x[64]; float ss = 0.f;
#pragma unroll
          for (int q = 0; q < 8; ++q)
#pragma unroll
              for (int e = 0; e < 4; ++e) { const float lo = __builtin_bit_cast(float, raw[q][e] << 16), hi = __builtin_bit_cast(float, raw[q][e] & 0xffff0000u); x[8 * q + 2 * e] = lo; x[8 * q + 2 * e + 1] = hi; ss += lo * lo + hi * hi; }
          const float r = rsqrtf(ss * (1.0f / 64.0f) + EPS); const LAS float* gv = GV + (hd < 8 ? 0 : 64);
#pragma unroll
          for (int d = 0; d < 64; ++d) x[d] *= r * gv[d];
          if (!is_ctx) { const LAS cpx* cs = CS + tl * 32;
#pragma unroll
              for (int hh = 0; hh < 2; ++hh)
#pragma unroll
                  for (int i = 0; i < 16; ++i) { const cpx c = cs[hh * 16 + i]; const float a = x[hh * 32 + i], b = x[hh * 32 + 16 + i]; x[hh * 32 + i] = a * c.x - b * c.y; x[hh * 32 + 16 + i] = b * c.x + a * c.y; } }
#pragma unroll
          for (int q = 0; q < 8; ++q) { u32x4v w; w.x = pk2(x[8 * q], x[8 * q + 1]); w.y = pk2(x[8 * q + 2], x[8 * q + 3]); w.z = pk2(x[8 * q + 4], x[8 * q + 5]); w.w = pk2(x[8 * q + 6], x[8 * q + 7]);
              *(u32x4v*)(prow + 8 * q) = w; } } }
    __syncthreads();
    LAS bf16* Pb = (LAS bf16*)(lds + 80 * 256 * 2);
    { const int ch = tid & 255, tl0 = (tid >> 8) * 32; const int win = 2 << (ch >> 6), hw = win >> 1; float sw = 0.f;
      for (int q = tl0 + 8 - hw; q < tl0 + 8 + hw; ++q) sw += bf2f(U[q * 256 + ch]);
#pragma unroll 4
      for (int tl = tl0; tl < tl0 + 32; ++tl) { const int t = seq_t0 + tl; int lo = t - hw, hi = lo + win; lo = lo < 0 ? 0 : lo; hi = hi > Lseq ? Lseq : hi;
          Pb[tl * 264 + ch] = (bf16)f2bf(sw * __builtin_amdgcn_rcpf((float)(hi - lo)) - bf2f(U[(tl + 8) * 256 + ch]));
          if (tl < tl0 + 31) sw += bf2f(U[(tl + 8 + hw) * 256 + ch]) - bf2f(U[(tl + 8 - hw) * 256 + ch]); } }
    __syncthreads();
    { typedef short bf16x8v __attribute__((ext_vector_type(8))); const int g = wid >> 1, mh = wid & 1, fr = lane & 15, fq = lane >> 4;
      const float* pw = A.pool_w + (size_t)(l * 4 + g) * 4096;
      bf16x8v bfrag[4][2];
#pragma unroll
      for (int nt = 0; nt < 4; ++nt)
#pragma unroll
          for (int ks = 0; ks < 2; ++ks) { float wv[8];
#pragma unroll
              for (int jj = 0; jj < 8; ++jj) wv[jj] = pw[(ks * 32 + fq * 8 + jj) * 64 + nt * 16 + fr];
              u32x4v pk; pk.x = pk2(wv[0], wv[1]); pk.y = pk2(wv[2], wv[3]); pk.z = pk2(wv[4], wv[5]); pk.w = pk2(wv[6], wv[7]); bfrag[nt][ks] = __builtin_bit_cast(bf16x8v, pk); }
#pragma unroll
      for (int mt = 0; mt < 2; ++mt) { bf16x8v afrag[2];
#pragma unroll
          for (int ks = 0; ks < 2; ++ks) afrag[ks] = *(const LAS bf16x8v*)(Pb + (mh * 32 + mt * 16 + fr) * 264 + g * 64 + ks * 32 + fq * 8);
#pragma unroll
          for (int nt = 0; nt < 4; ++nt) { f32x4 acc = (f32x4){0.f, 0.f, 0.f, 0.f};
#pragma unroll
              for (int ks = 0; ks < 2; ++ks) acc = __builtin_amdgcn_mfma_f32_16x16x32_bf16(afrag[ks], bfrag[nt][ks], acc, 0, 0, 0);
              const float ps = A.pool_scale[l * 256 + g * 64 + nt * 16 + fr];
#pragma unroll
              for (int jj = 0; jj < 4; ++jj) MIX[(size_t)(row0 + mh * 32 + mt * 16 + fq * 4 + jj) * 1024 + g * 64 + nt * 16 + fr] = (bf16)f2bf(acc[jj] * ps); } } }
    __syncthreads();
}

template <int L, int CH> __device__ __forceinline__ void hyena_item(const Args& A, int l, int item, LAS unsigned char* lds) {
    constexpr int N = 2 * L, TPF = NTHR / CH, NB = N + N / 16, NI = L / TPF, NCG = 256 / CH; static_assert(TPF * 16 == N && NI == 8, "geometry");
    const int tid = opaque_tid(); const int fi = tid / TPF, j = tid % TPF; const int bp = item / NCG, c0 = (item % NCG) * CH, c = c0 + fi;
    LAS bf16* raw = (LAS bf16*)lds;
    LAS cpx* buf = (LAS cpx*)(lds + 12 * L * CH) + fi * NB;
    const bf16* P = (const bf16*)(A.ws + WS_P); bf16* MIX = (bf16*)(A.ws + WS_MIX);
    const int rb0 = (2 * bp) * RPB + (L == SEQ ? 0 : SEQ), rb1 = rb0 + RPB;
    { constexpr int NLD = 6 * L * (CH / 2) / NTHR; static_assert(NLD * NTHR == 6 * L * (CH / 2), "load split"); unsigned rv[NLD];
#pragma unroll
      for (int k = 0; k < NLD; ++k) { const int i = tid + k * NTHR; const int cp = i % (CH / 2), rt = i / (CH / 2); const int bs = rt / L, t = rt % L; const int bb = bs / 3, sec = bs % 3;
          rv[k] = *(const unsigned*)(P + (size_t)((bb ? rb1 : rb0) + t) * INW + 256 + sec * 256 + c0 + 2 * cp); }
#pragma unroll
      for (int k = 0; k < NLD; ++k) { const int i = tid + k * NTHR; const int cp = i % (CH / 2), rt = i / (CH / 2); const int bs = rt / L, t = rt % L;
          *(LAS unsigned*)(raw + ((size_t)bs * L + t) * CH + 2 * cp) = rv[k]; } }
    __syncthreads();
    const cpx* KFb = (L == SEQ ? (const cpx*)(A.ws + WS_KF) : (const cpx*)(A.ws + WS_KFC)) + (size_t)l * 512 * N;
    float cw[3][3], cb[3];
#pragma unroll
    for (int sec = 0; sec < 3; ++sec) { cb[sec] = A.conv_b[l * 768 + sec * 256 + c];
#pragma unroll
        for (int tap = 0; tap < 3; ++tap) cw[sec][tap] = A.conv_w[(l * 3 + tap) * 768 + sec * 256 + c]; }
    const float hb0 = A.hy_bias[(l * 2 + 0) * 256 + c], hb1 = A.hy_bias[(l * 2 + 1) * 256 + c];
#define ZC(bb, sec, t) ([&]() -> float { const LAS bf16* bp_ = raw + ((size_t)((bb) * 3 + (sec)) * L) * CH + fi; \
        const float a_ = (t) > 0 ? bf2f(bp_[((t) - 1) * CH]) : 0.f, b_ = bf2f(bp_[(t) * CH]), c_ = (t) < L - 1 ? bf2f(bp_[((t) + 1) * CH]) : 0.f; \
        return cw[sec][0] * a_ + cw[sec][1] * b_ + cw[sec][2] * c_ + cb[sec]; }())
    float yv[NI][2];
#pragma unroll
    for (int i = 0; i < NI; ++i) { const int t = j + TPF * i; yv[i][0] = ZC(0, 0, t); yv[i][1] = ZC(1, 0, t); buf[PADI(t)] = mk2(yv[i][0], yv[i][1]); buf[PADI(t + L)] = mk2(0.f, 0.f); }
    __syncthreads();
#pragma unroll 1
    for (int o = 0; o < 2; ++o) {
        const cpx* kf = KFb + (size_t)(o * 256 + c) * N; cpx kfr[16];
#pragma unroll
        for (int k = 0; k < 16; ++k) kfr[k] = kf[j + k * TPF];
        fft_fwd<N>(buf, j);
#pragma unroll
        for (int k = 0; k < 16; ++k) { const int i = j + k * TPF; buf[PADI(i)] = cmul(buf[PADI(i)], kfr[k]); }
        __syncthreads();
        fft_inv<N>(buf, j);
        const float hb = o ? hb1 : hb0;
#pragma unroll
        for (int i = 0; i < NI; ++i) { const int t = j + TPF * i; const cpx cv = buf[PADI(t)];
            const float g0 = o ? ZC(0, 2, t) : ZC(0, 1, t), g1 = o ? ZC(1, 2, t) : ZC(1, 1, t);
            yv[i][0] = g0 * (cv.x + hb * yv[i][0]); yv[i][1] = g1 * (cv.y + hb * yv[i][1]); }
        __syncthreads();
        if (o == 0) {
#pragma unroll
            for (int i = 0; i < NI; ++i) { const int t = j + TPF * i; buf[PADI(t)] = mk2(yv[i][0], yv[i][1]); buf[PADI(t + L)] = mk2(0.f, 0.f); }
            __syncthreads();
        }
    }
#pragma unroll
    for (int i = 0; i < NI; ++i) { const int t = j + TPF * i; raw[((size_t)0 * L + t) * CH + fi] = (bf16)f2bf(yv[i][0]); raw[((size_t)3 * L + t) * CH + fi] = (bf16)f2bf(yv[i][1]); }
    __syncthreads();
#undef ZC
    for (int i = tid; i < 2 * L * (CH / 2); i += NTHR) { const int cp = i % (CH / 2), rt = i / (CH / 2); const int bb = rt / L, t = rt % L;
        const unsigned v = *(const LAS unsigned*)(raw + ((size_t)(bb * 3) * L + t) * CH + 2 * cp);
        *(unsigned*)(MIX + (size_t)((bb ? rb1 : rb0) + t) * 1024 + 256 + c0 + 2 * cp) = v; }
    __syncthreads();
}

__device__ __forceinline__ void ctx_finalize(const Args& A, const float* modl, int gate_idx, const float* g_next, const float* mod_next, int scale_idx, int G) {
    const int tid = opaque_tid(); const int lane = tid & 63, wid = tid >> 6; const int gw = blockIdx.x * NWAVES + wid, NGW = G * NWAVES;
    bf16* H = (bf16*)(A.ws + WS_H); bf16* HS = (bf16*)(A.ws + WS_Y); float* SS = (float*)(A.ws + WS_SS); const float* PART = (const float*)(A.ws + WS_P);
    for (int r = gw; r < 2048; r += NGW) { const size_t row = (size_t)(r >> 8) * RPB + SEQ + (r & 255); float ss = 0.f;
#pragma unroll
        for (int q = 0; q < 4; ++q) { const int d = 256 * q + 4 * lane;
            f32x4 p = *(const f32x4*)(PART + ((size_t)0 * 2048 + r) * 1024 + d); p += *(const f32x4*)(PART + ((size_t)1 * 2048 + r) * 1024 + d); p += *(const f32x4*)(PART + ((size_t)2 * 2048 + r) * 1024 + d); p += *(const f32x4*)(PART + ((size_t)3 * 2048 + r) * 1024 + d); p += *(const f32x4*)(PART + ((size_t)4 * 2048 + r) * 1024 + d); p += *(const f32x4*)(PART + ((size_t)5 * 2048 + r) * 1024 + d);
            const u32x2 hr = *(const u32x2*)(H + row * 1024 + d); f32x4 h; h[0] = __builtin_bit_cast(float, hr.x << 16); h[1] = __builtin_bit_cast(float, hr.x & 0xffff0000u); h[2] = __builtin_bit_cast(float, hr.y << 16); h[3] = __builtin_bit_cast(float, hr.y & 0xffff0000u);
            h += (*(const f32x4*)(modl + ((size_t)8 * 9 + gate_idx) * 1024 + d) * 0.5f) * p;
            ss += (h[0] * h[0] + h[1] * h[1]) + (h[2] * h[2] + h[3] * h[3]);
            u32x2 hw; hw.x = pk2(h[0], h[1]); hw.y = pk2(h[2], h[3]); *(u32x2*)(H + row * 1024 + d) = hw;
            const f32x4 y = h * (*(const f32x4*)(g_next + d) * (1.0f + *(const f32x4*)(mod_next + ((size_t)8 * 9 + scale_idx) * 1024 + d)));
            u32x2 w; w.x = pk2(y[0], y[1]); w.y = pk2(y[2], y[3]); *(u32x2*)(HS + row * 1024 + d) = w; }
        ss = wave_sum(ss);
        if (lane < 16) SS[row * 16 + lane] = (lane == 0) ? ss : 0.f; }
}

#define XB_TMO      128
#define XB_XCNT(j)  (256  + 64 * (j))
#define XB_XSUB(j)  (1280 + 64 * (j))
#define XB_XGEN(j)  (2304 + 64 * (j))
#define XB_TOP      3328
#define XB_TOPGEN   3392
#define XCD_BAR_WORDS 3456
#define XB_SPIN_CAP (1u << 18)

__device__ __forceinline__ unsigned xb_ld(unsigned* p)              { return __hip_atomic_load(p, __ATOMIC_RELAXED, __HIP_MEMORY_SCOPE_AGENT); }
__device__ __forceinline__ unsigned xb_add(unsigned* p, unsigned v) { return __hip_atomic_fetch_add(p, v, __ATOMIC_RELAXED, __HIP_MEMORY_SCOPE_AGENT); }
__device__ __forceinline__ unsigned xb_xcc_id() { return (unsigned)__builtin_amdgcn_s_getreg((3 << 11) | 20) & 0xFu; }
#define XB_SPIN(cond, bar) do { unsigned _sp = 0; while (cond) { __builtin_amdgcn_s_sleep(1); \
    if ((++_sp & 255u) == 0u) { if (xb_ld(&(bar)[XB_TMO])) break; if (_sp > XB_SPIN_CAP) { atomicAdd(&(bar)[XB_TMO], 1u); break; } } } } while (0)

struct XcdBarrier {
    unsigned* bar; unsigned x;
    volatile LAS unsigned* st;
};

__device__ __forceinline__ XcdBarrier xcd_barrier_post(unsigned* bar, volatile LAS unsigned* st) {
    XcdBarrier b; b.bar = bar; b.x = xb_xcc_id(); b.st = st;
    if (threadIdx.x == 0) (void)xb_add(&bar[XB_XCNT(b.x)], 1u);
    return b;
}
__device__ __forceinline__ void xcd_barrier_complete(unsigned* bar, unsigned x, unsigned& nloc, unsigned& nx) {
    const unsigned G = gridDim.x * gridDim.y * gridDim.z;
    unsigned sum, cnt, mine, sp = 0u;
    for (;;) {
        sum = 0u; cnt = 0u; mine = 0u;
#pragma unroll
        for (unsigned j = 0; j < 16; ++j) { const unsigned c = xb_ld(&bar[XB_XCNT(j)]); sum += c; cnt += (c > 0u) ? 1u : 0u; mine = (j == x) ? c : mine; }
        if (sum == G) break;
        __builtin_amdgcn_s_sleep(1);
        if ((++sp & 255u) == 0u) { if (xb_ld(&bar[XB_TMO])) break; if (sp > XB_SPIN_CAP) { atomicAdd(&bar[XB_TMO], 1u); break; } }
    }
    nloc = mine > 0u ? mine : 1u; nx = cnt > 0u ? cnt : 1u;
}

__device__ __forceinline__ void xcd_barrier(const XcdBarrier& b) {
    asm volatile("s_waitcnt vmcnt(0)" ::: "memory");
    __syncthreads();
    if (threadIdx.x == 0) {
        unsigned* bar = b.bar;
        __builtin_amdgcn_s_waitcnt(0);
        unsigned nloc = b.st[0], nx = b.st[1];
        if (nloc == 0u) { xcd_barrier_complete(bar, b.x, nloc, nx); b.st[0] = nloc; b.st[1] = nx; }
        const unsigned old = xb_add(&bar[XB_XSUB(b.x)], 1u);
        const unsigned gen = old / nloc;
        if (old + 1u == (gen + 1u) * nloc) {
            __builtin_amdgcn_fence(__ATOMIC_RELEASE, "agent");
            asm volatile("s_waitcnt vmcnt(0)" ::: "memory");
            const unsigned og = xb_add(&bar[XB_TOP], 1u);
            const unsigned tg = og / nx;
            if (og + 1u == (tg + 1u) * nx) xb_add(&bar[XB_TOPGEN], 1u);
            else XB_SPIN(xb_ld(&bar[XB_TOPGEN]) == tg, bar);
            __builtin_amdgcn_fence(__ATOMIC_ACQUIRE, "agent");
            xb_add(&bar[XB_XGEN(b.x)], 1u);
            asm volatile("s_waitcnt vmcnt(0)" ::: "memory");
        } else {
            XB_SPIN(xb_ld(&bar[XB_XGEN(b.x)]) == gen, bar);
            __builtin_amdgcn_fence(__ATOMIC_ACQUIRE, "agent");
            asm volatile("s_waitcnt vmcnt(0)" ::: "memory");
        }
    }
    __syncthreads();
}

__global__ void __launch_bounds__(NTHR, 2) fwd_megakernel(Args A) {
    extern __shared__ __attribute__((aligned(16))) unsigned char lds_raw[];
    LAS unsigned char* lds = (LAS unsigned char*)lds_raw;
    cg::grid_group grid = cg::this_grid();
#define GRID_SYNC_CG() do { asm volatile("s_waitcnt vmcnt(0)" ::: "memory"); grid.sync(); if (threadIdx.x == 0) { __builtin_amdgcn_fence(__ATOMIC_ACQUIRE, "agent"); asm volatile("s_waitcnt vmcnt(0)" ::: "memory"); } __syncthreads(); } while (0)
    volatile LAS unsigned* bst = (volatile LAS unsigned*)(lds + LDS_BYTES - 64);
    if (threadIdx.x < 16) bst[threadIdx.x] = 0u;
    __syncthreads();
    (void)xcd_barrier_post((unsigned*)(A.ws + WS_BAR), bst);
#define GRID_SYNC() do { XcdBarrier b_; b_.bar = (unsigned*)(A.ws + WS_BAR); b_.x = xb_xcc_id(); b_.st = (volatile LAS unsigned*)(lds + LDS_BYTES - 64); xcd_barrier(b_); } while (0)
    const int tid = opaque_tid(), lane = tid & 63, wid = __builtin_amdgcn_readfirstlane(tid >> 6); const int G = gridDim.x, bid = blockIdx.x;
    unsigned char* ws = A.ws;
    bf16* Y = (bf16*)(ws + WS_Y); bf16* ACT = (bf16*)(ws + WS_ACT); bf16* P = (bf16*)(ws + WS_P); bf16* MIX = (bf16*)(ws + WS_MIX); bf16* H = (bf16*)(ws + WS_H);

#ifdef DEBUG_NANFILL
    { f32x4 q; q.x = q.y = q.z = q.w = __builtin_nanf(""); f32x4* p = (f32x4*)(ws + WS_H); const size_t n = (WS_KF - WS_H) / 16; for (size_t i = (size_t)bid * NTHR + tid; i < n; i += (size_t)G * NTHR) p[i] = q; }
    GRID_SYNC();
#endif
    for (int it = bid; it < 144; it += G) mod_item(A, it, lds);
    for (int it = bid; it < 576; it += G) filter_item(A, it, lds);
    { LAS float* scr = (LAS float*)(lds + wid * 16384); const int gw = bid * NWAVES + wid, NGW = G * NWAVES;
      constexpr int I_GU = 16 * 88, I_D = 44 * 32, I_IN = 16 * 56, I_OUT = 16 * 32;
      constexpr int PER_L = 4 * I_GU + 2 * I_D + I_IN + I_OUT;
      const int share0 = (bid < 144) ? bid * 3 : 432 + (bid - 144) * 5, nshare = (bid < 144) ? 3 : 5; const bool wsplit = (G == 256);
      const int it_lo = wsplit ? share0 * 40 + wid : gw, it_hi = wsplit ? ((share0 + nshare) * 40 < DEPTH * PER_L ? (share0 + nshare) * 40 : DEPTH * PER_L) : DEPTH * PER_L, it_st = wsplit ? NWAVES : NGW;
      for (int it = it_lo; it < it_hi; it += it_st) { const int l = it / PER_L; int r = it % PER_L;
          if (r < 4 * I_GU) { const int f = r / (2 * I_GU), gu = (r / I_GU) & 1, ii = r % I_GU;
              transpose_item((gu ? A.w_up : A.w_gate) + (size_t)(l * 2 + f) * 1024 * DFF, 1024, DFF, (bf16*)(ws + WS_WGU) + (size_t)(l * 2 + f) * 5632 * 1024, gu ? 2 : 1, scr, ii, lane); continue; }
          r -= 4 * I_GU;
          if (r < 2 * I_D) { const int f = r / I_D, ii = r % I_D;
              transpose_item(A.w_down + (size_t)(l * 2 + f) * DFF * 1024, DFF, 1024, (bf16*)(ws + WS_WD) + (size_t)(l * 2 + f) * 1024 * DFF, 0, scr, ii, lane); continue; }
          r -= 2 * I_D;
          if (r < I_IN) { transpose_item(A.w_in + (size_t)l * 1024 * INW, 1024, INW, (bf16*)(ws + WS_WIN) + (size_t)l * INW * 1024, 0, scr, r, lane); continue; }
          r -= I_IN;
          transpose_item(A.w_out + (size_t)l * 1024 * 1024, 1024, 1024, (bf16*)(ws + WS_WOUT) + (size_t)l * 1024 * 1024, 0, scr, r, lane); } }
    GRID_SYNC_CG();
    for (int it = bid; it < DEPTH * 256; it += G) filter_fft_item<SEQ, 2>(A, it, lds);
    for (int it = bid; it < (DEPTH - 1) * 32; it += G) filter_fft_item<CTXL, 16>(A, it, lds);
    sb_items(A, G, lds);
    __syncthreads();
    prologue_rows(A, G);
    GRID_SYNC();

    bf16* HS = Y; float* SS = (float*)(ws + WS_SS);
#pragma unroll 1
    for (int l = 0; l < DEPTH; ++l) {
        const bool last = (l == DEPTH - 1);
        const float* modl = (const float*)(ws + WS_MOD) + (size_t)l * 9 * 9216;
        const float* SBl = (const float*)(ws + WS_SB) + (size_t)l * SB_PER_L;
#pragma unroll 1
        for (int f = 0; f < 2; ++f) {
            if (f == 1) {
                { pg8::Gemm g{HS, (const bf16*)(ws + WS_WIN) + (size_t)l * INW * 1024, MROWS, INW, 1024}; pg8::TileOrder S; S.init(MROWS, INW, G, bid, 0);
                  pg8::EpiStoreBf16 E{P, INW, SS, SBl + SB_IN}; pg8::gemm_phase<pg8::EpiStoreBf16, pg8::TileOrder, true, true>(lds, g, S, E); }
                GRID_SYNC();
                for (int it = bid; it < MROWS / 64; it += G) prep_item(A, l, it, lds);
                GRID_SYNC();
                const int vcu = (G % 8 == 0) ? (bid & 7) * (G >> 3) + (bid >> 3) : bid;
                for (int u = vcu; u < 512 + (last ? 0 : 64); u += G) {
                    const attn_body::bf16* Pb = (const attn_body::bf16*)P; attn_body::bf16* Mb = (attn_body::bf16*)MIX;
                    if (u < 512) { const int qb = u & 7, h = (u >> 3) & 7, b = u >> 6; const size_t kr = (size_t)b * RPB, qr = kr + qb * 256;
                        attn_body::attn_unit<8>(Pb + qr * INW + 1024 + h * 64, Pb + kr * INW + 1536 + (h >> 2) * 64, Pb + kr * INW + 1664 + (h >> 2) * 64, Mb + qr * 1024 + 512 + h * 64, 36, (char*)lds_raw); }
                    else { const int h = (u - 512) & 7, b = (u - 512) >> 3; const size_t kr = (size_t)b * RPB + SEQ;
                        attn_body::attn_unit<8>(Pb + kr * INW + 1024 + h * 64, Pb + kr * INW + 1536 + (h >> 2) * 64, Pb + kr * INW + 1664 + (h >> 2) * 64, Mb + kr * 1024 + 512 + h * 64, 4, (char*)lds_raw); }
                }
                __syncthreads();
                for (int it = bid; it < 512; it += G) hyena_item<SEQ, 2>(A, l, it, lds);
                if (!last) for (int it = bid; it < 64; it += G) hyena_item<CTXL, 16>(A, l, it, lds);
                GRID_SYNC();
                { pg8::Gemm g{MIX, (const bf16*)(ws + WS_WOUT) + (size_t)l * 1024 * 1024, MROWS, 1024, 1024}; pg8::TileOrder S; S.init(MROWS, 1024, G, bid, last ? 1 : 0);
                  pg8::EpiResid<false> E{H, modl, nullptr, 5, HS, A.norm_g + ((size_t)l * 3 + 2) * 1024, modl, 7, SS, nullptr}; pg8::gemm_phase<pg8::EpiResid<false>, pg8::TileOrder, true, true>(lds, g, S, E); }
                GRID_SYNC();
            }
            { pg8::Gemm g{HS, (const bf16*)(ws + WS_WGU) + (size_t)(l * 2 + f) * 5632 * 1024, MROWS, 5632, 1024}; pg8::TileOrder S; S.init(MROWS, 5632, G, bid, (last && f == 1) ? 1 : 0);
              pg8::EpiSwiGLU E{ACT, SS, SBl + (f ? SB_G2 : 0)}; pg8::gemm_phase<pg8::EpiSwiGLU, pg8::TileOrder, true, true>(lds, g, S, E); }
            GRID_SYNC();
            { pg8::Gemm g{ACT, (const bf16*)(ws + WS_WD) + (size_t)(l * 2 + f) * 1024 * DFF, MROWS, 1024, DFF}; pg8::TileOrder S; S.init(MROWS, 1024, G, bid, (last && f == 1) ? 1 : 2);
              const int ln = f ? (last ? l : l + 1) : l;
              const float* gn = A.norm_g + ((size_t)ln * 3 + (f ? 0 : 1)) * 1024; const float* mn = (const float*)(ws + WS_MOD) + (size_t)ln * 9 * 9216;
              pg8::EpiResid<true> E{H, modl, (last && f == 1) ? A.out : nullptr, f ? 8 : 2, HS, gn, mn, f ? 1 : 4, SS, (float*)(ws + WS_P)};
              pg8::gemm_phase<pg8::EpiResid<true>, pg8::TileOrder, true, true>(lds, g, S, E);
              if (!(last && f == 1)) { GRID_SYNC(); ctx_finalize(A, modl, f ? 8 : 2, gn, mn, f ? 1 : 4, G); GRID_SYNC(); } }
        }
    }
}

extern "C" void kernel_launch(void* const* d_in, const int* in_sizes, int n_in, void* d_out, int out_size, void* d_ws, size_t ws_size, hipStream_t stream) {
    static int grid = 0;
    if (grid == 0) {
        if (n_in != 25 || ws_size < WS_END) { fprintf(stderr, "kernel_launch: expected 25 inputs and >= %zu bytes of workspace; got %d, %zu\n", (size_t)WS_END, n_in, ws_size); grid = -1; return; }
        int dev = 0, cus = 0, per_cu = 0;
        hipGetDevice(&dev); hipDeviceGetAttribute(&cus, hipDeviceAttributeMultiprocessorCount, dev);
        if (hipFuncSetAttribute((const void*)fwd_megakernel, hipFuncAttributeMaxDynamicSharedMemorySize, LDS_BYTES) != hipSuccess) { fprintf(stderr, "kernel_launch: hipFuncSetAttribute failed\n"); grid = -1; return; }
        if (hipOccupancyMaxActiveBlocksPerMultiprocessor(&per_cu, (const void*)fwd_megakernel, NTHR, LDS_BYTES) != hipSuccess || per_cu < 1) { fprintf(stderr, "kernel_launch: occupancy query gave %d\n", per_cu); per_cu = 1; }
        (void)hipGetLastError();
        grid = cus * 1;
    }
    if (grid < 0) return;
    if (hipMemsetAsync((char*)d_ws + WS_BAR, 0, WS_BAR_BYTES, stream) != hipSuccess) { fprintf(stderr, "kernel_launch: memset failed\n"); return; }
    Args a{};
    const float** ap = (const float**)&a;
    for (int i = 0; i < 25; ++i) ap[i] = (const float*)d_in[i];
    a.out = (float*)d_out; a.ws = (unsigned char*)d_ws;
    void* args[] = {&a};
    hipError_t e = hipLaunchCooperativeKernel((const void*)fwd_megakernel, dim3(grid), dim3(NTHR), args, LDS_BYTES, stream);
    if (e != hipSuccess) fprintf(stderr, "cooperative launch failed: %s (grid %d)\n", hipGetErrorString(e), grid);
}
```
